# Optimizing an MI355X kernel written in HIP

```python
import jax, jax.numpy as jnp
from jax import lax
import numpy as np

D_MODEL = 1024
BATCH = 8
SEQ = 2048
DEPTH = 2

N_MIXERS = 2
N_CONV_LAYERS = (DEPTH + 1) // 2
N_POOL_LAYERS = DEPTH // 2
CONV_WIDTH = 3
POOL_WINDOWS = (2, 4, 8, 16)
N_POOL_GROUPS = len(POOL_WINDOWS)
POOL_GROUP_W = D_MODEL // N_POOL_GROUPS
N_KEYS = 128
N_EXPERTS = N_KEYS * N_KEYS
PEER_HEADS = 8
PEER_TOPK = 16
D_QUERY = 256
D_HALF = D_QUERY // 2
TOK_CHUNK = 128
N_MOD = 6
EPS = 1e-6

kernel_name = "hybrid_shortconv_pool_peer_adaln"


def rmsnorm(x, g):
    xf = x.astype(jnp.float32)
    y = xf * lax.rsqrt(jnp.mean(xf * xf, axis=-1, keepdims=True) + EPS)
    return (y * g.astype(jnp.float32)).astype(x.dtype)


def modulate(h, shift, scale):
    return h * (1.0 + scale[:, None, :]) + shift[:, None, :]


def short_conv_mixer(h, w_in, conv_w, w_out):
    S = h.shape[1]
    proj = h @ w_in
    b_gate, c_gate, u = jnp.split(proj, 3, axis=-1)
    v = c_gate * u
    vp = jnp.pad(v, ((0, 0), (CONV_WIDTH - 1, 0), (0, 0)))
    conv = conv_w[0] * vp[:, 0:S]
    for k in range(1, CONV_WIDTH):
        conv = conv + conv_w[k] * vp[:, k:k + S]
    return (b_gate * conv) @ w_out


def pool_mixer(h, w_in, w_grp, scale, w_out):
    B, S, D = h.shape
    u = (h @ w_in).reshape(B, S, N_POOL_GROUPS, POOL_GROUP_W)
    cs = jnp.cumsum(u.astype(jnp.float32), axis=1)
    t = jnp.arange(S)
    pooled = []
    for g, w in enumerate(POOL_WINDOWS):
        cg = cs[:, :, g]
        lag = jnp.pad(cg, ((0, 0), (w, 0), (0, 0)))[:, :S]
        cnt = jnp.minimum(t + 1, w).astype(jnp.float32)[None, :, None]
        pooled.append((cg - lag) / cnt)
    pooled = jnp.stack(pooled, axis=2).astype(u.dtype) - u
    z = jnp.einsum('bsgi,gio->bsgo', pooled, w_grp).reshape(B, S, D) * scale
    return z @ w_out


def peer_ffn(h, w_q, k1, k2, u_tab, v_tab):
    B, S, D = h.shape
    T = B * S
    ht = h.reshape(T, D)
    q = (ht @ w_q).reshape(T, PEER_HEADS, 2, D_HALF)
    s1 = jnp.einsum('thd,nd->thn', q[:, :, 0], k1)
    s2 = jnp.einsum('thd,nd->thn', q[:, :, 1], k2)
    v1, i1 = lax.top_k(s1, PEER_TOPK)
    v2, i2 = lax.top_k(s2, PEER_TOPK)
    cand = (v1[..., :, None] + v2[..., None, :]).reshape(T, PEER_HEADS, PEER_TOPK * PEER_TOPK)
    sc, flat = lax.top_k(cand, PEER_TOPK)
    e1 = jnp.take_along_axis(i1, flat // PEER_TOPK, axis=-1)
    e2 = jnp.take_along_axis(i2, flat % PEER_TOPK, axis=-1)
    idx = e1 * N_KEYS + e2
    gate = jax.nn.softmax(sc.astype(jnp.float32), axis=-1).astype(h.dtype)
    n_chunks = T // TOK_CHUNK

    def block(args):
        xc, ic, gc = args
        ug = u_tab[ic]
        act = jax.nn.gelu(jnp.einsum('td,thkd->thk', xc, ug), approximate=False)
        vg = v_tab[ic]
        return jnp.einsum('thk,thkd->td', gc * act, vg)

    out = lax.map(block, (ht.reshape(n_chunks, TOK_CHUNK, D),
                          idx.reshape(n_chunks, TOK_CHUNK, PEER_HEADS, PEER_TOPK),
                          gate.reshape(n_chunks, TOK_CHUNK, PEER_HEADS, PEER_TOPK)))
    return out.reshape(B, S, D)


def setup_inputs(seed: int = 0) -> dict:
    key = jax.random.key(seed)
    ks = jax.random.split(key, 20)
    D = D_MODEL
    nrm = lambda k, shape, s: jax.random.normal(k, shape, jnp.float32) * s
    inv = D ** -0.5
    return {
        "x": nrm(ks[0], (BATCH, SEQ, D), 1.0),
        "c": nrm(ks[1], (BATCH, D), 1.0),
        "norm1_g": 1.0 + nrm(ks[2], (DEPTH, D), 0.05),
        "norm2_g": 1.0 + nrm(ks[3], (DEPTH, D), 0.05),
        "w_mod": nrm(ks[4], (DEPTH, D, N_MOD * D), 0.5 * inv),
        "b_mod": nrm(ks[5], (DEPTH, N_MOD * D), 0.02),
        "conv_w_in": nrm(ks[6], (N_CONV_LAYERS, D, 3 * D), inv),
        "conv_w": nrm(ks[7], (N_CONV_LAYERS, CONV_WIDTH, D), CONV_WIDTH ** -0.5),
        "conv_w_out": nrm(ks[8], (N_CONV_LAYERS, D, D), inv),
        "pool_w_in": nrm(ks[9], (N_POOL_LAYERS, D, D), inv),
        "pool_w_grp": nrm(ks[10], (N_POOL_LAYERS, N_POOL_GROUPS, POOL_GROUP_W, POOL_GROUP_W), POOL_GROUP_W ** -0.5),
        "pool_scale": 1.0 + nrm(ks[11], (N_POOL_LAYERS, D), 0.1),
        "pool_w_out": nrm(ks[12], (N_POOL_LAYERS, D, D), inv),
        "peer_w_q": nrm(ks[13], (DEPTH, D, PEER_HEADS * D_QUERY), inv),
        "peer_k1": nrm(ks[14], (DEPTH, N_KEYS, D_HALF), D_HALF ** -0.5),
        "peer_k2": nrm(ks[15], (DEPTH, N_KEYS, D_HALF), D_HALF ** -0.5),
        "peer_u": nrm(ks[16], (DEPTH, N_EXPERTS, D), inv),
        "peer_v": nrm(ks[17], (DEPTH, N_EXPERTS, D), 0.5),
        "final_g": 1.0 + nrm(ks[18], (D,), 0.05),
    }


def reference(x, c, norm1_g, norm2_g, w_mod, b_mod, conv_w_in, conv_w, conv_w_out,
              pool_w_in, pool_w_grp, pool_scale, pool_w_out,
              peer_w_q, peer_k1, peer_k2, peer_u, peer_v, final_g):
    c_act = jax.nn.silu(c)
    for i in range(DEPTH):
        mod = c_act @ w_mod[i] + b_mod[i]
        sh1, sc1, g1, sh2, sc2, g2 = jnp.split(mod, N_MOD, axis=-1)
        h = modulate(rmsnorm(x, norm1_g[i]), sh1, sc1)
        j = i // N_MIXERS
        if i % N_MIXERS == 0:
            y = short_conv_mixer(h, conv_w_in[j], conv_w[j], conv_w_out[j])
        else:
            y = pool_mixer(h, pool_w_in[j], pool_w_grp[j], pool_scale[j], pool_w_out[j])
        x = x + g1[:, None, :] * y
        h = modulate(rmsnorm(x, norm2_g[i]), sh2, sc2)
        x = x + g2[:, None, :] * peer_ffn(h, peer_w_q[i], peer_k1[i], peer_k2[i], peer_u[i], peer_v[i])
    return rmsnorm(x, final_g)
```

```cpp
#include <hip/hip_runtime.h>
#include <cstdio>
#include <cstdint>
#include <utility>

typedef unsigned short bf16_t;
typedef short bf16x8 __attribute__((ext_vector_type(8)));
typedef float f32x4 __attribute__((ext_vector_type(4)));

constexpr int D = 1024, NB = 8, SEQ = 2048, T = NB * SEQ;
constexpr int NE = 16384, NH = 8, TOPK = 16, NSEL = NH * TOPK;
constexpr float EPS = 1e-6f;

__device__ __forceinline__ unsigned f2bf(float f) { unsigned u = __builtin_bit_cast(unsigned, f); return (u + 0x7fffu + ((u >> 16) & 1u)) >> 16; }
__device__ __forceinline__ unsigned pk2(float lo, float hi) { return f2bf(lo) | (f2bf(hi) << 16); }
__device__ __forceinline__ float bf_lo(unsigned u) { return __builtin_bit_cast(float, u << 16); }
__device__ __forceinline__ float bf_hi(unsigned u) { return __builtin_bit_cast(float, u & 0xffff0000u); }
__device__ __forceinline__ float wave_sum(float v) {
#pragma unroll
    for (int o = 32; o > 0; o >>= 1) v += __shfl_xor(v, o);
    return v;
}

template <int MODE>
__global__ void __launch_bounds__(256) k_transpose_cvt(const float* __restrict__ W, bf16_t* __restrict__ Wt, int K, int N) {
    __shared__ float tile[32][33];
    const int n0 = blockIdx.x * 32, k0 = blockIdx.y * 32;
    const int tx = threadIdx.x & 31, ty = threadIdx.x >> 5;
#pragma unroll
    for (int i = 0; i < 4; ++i) tile[ty + 8 * i][tx] = W[(size_t)(k0 + ty + 8 * i) * N + n0 + tx];
    __syncthreads();
#pragma unroll
    for (int i = 0; i < 4; ++i) {
        int n = n0 + ty + 8 * i, p = n;
        if (MODE == 1 && n >= 1024) { const int j = (n - 1024) & 1023, isu = (n >= 2048); p = 1024 + (j >> 4) * 32 + isu * 16 + (j & 15); }
        Wt[(size_t)p * K + k0 + tx] = (bf16_t)f2bf(tile[tx][ty + 8 * i]);
    }
}
__global__ void __launch_bounds__(256) k_cvt(const float* __restrict__ src, bf16_t* __restrict__ dst, size_t n8) {
    for (size_t i = (size_t)blockIdx.x * 256 + threadIdx.x; i < n8; i += (size_t)gridDim.x * 256) {
        const float4 a = ((const float4*)src)[2 * i], b = ((const float4*)src)[2 * i + 1];
        uint4 o; o.x = pk2(a.x, a.y); o.y = pk2(a.z, a.w); o.z = pk2(b.x, b.y); o.w = pk2(b.z, b.w);
        ((uint4*)dst)[i] = o;
    }
}

__global__ void __launch_bounds__(256) k_mod_partial(const float* __restrict__ c, const float* __restrict__ w_mod, float* __restrict__ part) {
    __shared__ float ca[8][128];
    const int n = blockIdx.x * 256 + threadIdx.x, kc = blockIdx.y, l = blockIdx.z;
    for (int i = threadIdx.x; i < 8 * 128; i += 256) { const int b = i >> 7, k = i & 127; const float v = c[b * D + kc * 128 + k]; ca[b][k] = v / (1.0f + __expf(-v)); }
    __syncthreads();
    float acc[8] = {0, 0, 0, 0, 0, 0, 0, 0};
    const float* w = w_mod + (size_t)l * D * 6144 + (size_t)(kc * 128) * 6144 + n;
#pragma unroll 8
    for (int k = 0; k < 128; ++k) { const float wv = w[(size_t)k * 6144];
#pragma unroll
        for (int b = 0; b < 8; ++b) acc[b] += ca[b][k] * wv; }
#pragma unroll
    for (int b = 0; b < 8; ++b) part[(((size_t)l * 8 + kc) * 8 + b) * 6144 + n] = acc[b];
}
__global__ void __launch_bounds__(256) k_mod_reduce(const float* __restrict__ part, const float* __restrict__ b_mod, float* __restrict__ mod) {
    const int i = blockIdx.x * 256 + threadIdx.x;
    const int n = i % 6144, b = (i / 6144) & 7, l = i / (6144 * 8);
    float s = b_mod[l * 6144 + n];
#pragma unroll
    for (int kc = 0; kc < 8; ++kc) s += part[(((size_t)l * 8 + kc) * 8 + b) * 6144 + n];
    mod[i] = s;
}

template <int MODE>
__global__ void __launch_bounds__(256) k_rmsnorm(const float* x, const float* __restrict__ g, const float* __restrict__ sh, const float* __restrict__ sc,
                                                 bf16_t* ob, float* of) {
    const int lane = threadIdx.x & 63, row = blockIdx.x * 4 + (threadIdx.x >> 6), b = row / SEQ;
    const float4* xr = (const float4*)(x + (size_t)row * D);
    float4 v[4]; float ss = 0.f;
#pragma unroll
    for (int i = 0; i < 4; ++i) { v[i] = xr[lane + 64 * i]; ss += v[i].x * v[i].x + v[i].y * v[i].y + v[i].z * v[i].z + v[i].w * v[i].w; }
    ss = wave_sum(ss);
    const float r = rsqrtf(ss * (1.0f / D) + EPS);
#pragma unroll
    for (int i = 0; i < 4; ++i) {
        const int c4 = lane + 64 * i; const float4 gg = ((const float4*)g)[c4];
        float4 y; y.x = v[i].x * r * gg.x; y.y = v[i].y * r * gg.y; y.z = v[i].z * r * gg.z; y.w = v[i].w * r * gg.w;
        if (MODE == 0) {
            const float4 s1 = ((const float4*)(sc + (size_t)b * 6144))[c4], s0 = ((const float4*)(sh + (size_t)b * 6144))[c4];
            y.x = y.x * (1.f + s1.x) + s0.x; y.y = y.y * (1.f + s1.y) + s0.y; y.z = y.z * (1.f + s1.z) + s0.z; y.w = y.w * (1.f + s1.w) + s0.w;
            uint2 o; o.x = pk2(y.x, y.y); o.y = pk2(y.z, y.w);
            ((uint2*)(ob + (size_t)row * D))[c4] = o;
        } else ((float4*)(of + (size_t)row * D))[c4] = y;
    }
}

constexpr int GEMM_LDS = 65536;
template <class Epi>
__device__ __forceinline__ void gemm_tile(const bf16_t* __restrict__ A, int lda, const bf16_t* __restrict__ Bt, int ldb, int K, int m0, int n0, const Epi& epi, unsigned char* lds) {
    const int tid = threadIdx.x, lane = tid & 63, wid = tid >> 6, wr = wid >> 1, wc = wid & 1;
    const int fr = lane & 15, fq = lane >> 4;
    f32x4 acc[4][4];
#pragma unroll
    for (int n = 0; n < 4; ++n)
#pragma unroll
        for (int m = 0; m < 4; ++m) acc[n][m] = (f32x4){0.f, 0.f, 0.f, 0.f};
    uint4 ra[4], rb[4];
    const int srow = tid >> 3, sch = tid & 7;
    const bf16_t* ag = A + (size_t)(m0 + srow) * lda + sch * 8;
    const bf16_t* bg = Bt + (size_t)(n0 + srow) * ldb + sch * 8;
    const int soff = srow * 128 + ((sch ^ (srow & 7)) << 4);
    const int nk = K >> 6;
#pragma unroll
    for (int i = 0; i < 4; ++i) { ra[i] = *(const uint4*)(ag + (size_t)(32 * i) * lda); rb[i] = *(const uint4*)(bg + (size_t)(32 * i) * ldb); }
#pragma unroll
    for (int i = 0; i < 4; ++i) { *(uint4*)(lds + soff + i * 4096) = ra[i]; *(uint4*)(lds + 16384 + soff + i * 4096) = rb[i]; }
    __syncthreads();
    for (int kt = 0; kt < nk; ++kt) {
        unsigned char* cur = lds + (kt & 1) * 32768;
        unsigned char* nxt = lds + ((kt + 1) & 1) * 32768;
        const int kn = (kt + 1 < nk ? kt + 1 : kt) * 64;
#pragma unroll
        for (int i = 0; i < 4; ++i) { ra[i] = *(const uint4*)(ag + (size_t)(32 * i) * lda + kn); rb[i] = *(const uint4*)(bg + (size_t)(32 * i) * ldb + kn); }
#pragma unroll
        for (int ks = 0; ks < 2; ++ks) {
            bf16x8 af[4], bf[4];
#pragma unroll
            for (int m = 0; m < 4; ++m) { const int row = wr * 64 + m * 16 + fr; af[m] = *(const bf16x8*)(cur + row * 128 + (((ks * 4 + fq) ^ (row & 7)) << 4)); }
#pragma unroll
            for (int n = 0; n < 4; ++n) { const int row = wc * 64 + n * 16 + fr; bf[n] = *(const bf16x8*)(cur + 16384 + row * 128 + (((ks * 4 + fq) ^ (row & 7)) << 4)); }
#pragma unroll
            for (int n = 0; n < 4; ++n)
#pragma unroll
                for (int m = 0; m < 4; ++m) acc[n][m] = __builtin_amdgcn_mfma_f32_16x16x32_bf16(bf[n], af[m], acc[n][m], 0, 0, 0);
        }
#pragma unroll
        for (int i = 0; i < 4; ++i) { *(uint4*)(nxt + soff + i * 4096) = ra[i]; *(uint4*)(nxt + 16384 + soff + i * 4096) = rb[i]; }
        __syncthreads();
    }
    epi(acc, m0 + wr * 64 + fr, n0 + wc * 64 + fq * 4);
}

struct EpiBf16 {
    bf16_t* O; int ldc; int pad;
    __device__ __forceinline__ void operator()(const f32x4 (&acc)[4][4], int row0, int col0) const {
#pragma unroll
        for (int m = 0; m < 4; ++m)
#pragma unroll
            for (int n = 0; n < 4; ++n) { uint2 o; o.x = pk2(acc[n][m][0], acc[n][m][1]); o.y = pk2(acc[n][m][2], acc[n][m][3]);
                *(uint2*)(O + (size_t)(row0 + 16 * m) * ldc + col0 + 16 * n) = o; }
    }
};
struct EpiF32 {
    float* O; int ldc; int pad;
    __device__ __forceinline__ void operator()(const f32x4 (&acc)[4][4], int row0, int col0) const {
#pragma unroll
        for (int m = 0; m < 4; ++m)
#pragma unroll
            for (int n = 0; n < 4; ++n) *(f32x4*)(O + (size_t)(row0 + 16 * m) * ldc + col0 + 16 * n) = acc[n][m];
    }
};
struct EpiScaleBf16 {
    bf16_t* O; const float* scale; int ldc; int pad;
    __device__ __forceinline__ void operator()(const f32x4 (&acc)[4][4], int row0, int col0) const {
#pragma unroll
        for (int n = 0; n < 4; ++n) { const f32x4 s = *(const f32x4*)(scale + col0 + 16 * n);
#pragma unroll
            for (int m = 0; m < 4; ++m) { const f32x4 v = acc[n][m] * s; uint2 o; o.x = pk2(v[0], v[1]); o.y = pk2(v[2], v[3]);
                *(uint2*)(O + (size_t)(row0 + 16 * m) * ldc + col0 + 16 * n) = o; } }
    }
};
struct EpiResid {
    const float* Xin; float* Xout; const float* gate;
    __device__ __forceinline__ void operator()(const f32x4 (&acc)[4][4], int row0, int col0) const {
#pragma unroll
        for (int m = 0; m < 4; ++m) { const int row = row0 + 16 * m, b = row / SEQ;
#pragma unroll
            for (int n = 0; n < 4; ++n) { const int col = col0 + 16 * n;
                const f32x4 xi = *(const f32x4*)(Xin + (size_t)row * D + col), g = *(const f32x4*)(gate + (size_t)b * 6144 + col);
                *(f32x4*)(Xout + (size_t)row * D + col) = xi + g * acc[n][m]; } }
    }
};
struct EpiConvIn {
    bf16_t* Bg; bf16_t* Vv;
    __device__ __forceinline__ void operator()(const f32x4 (&acc)[4][4], int row0, int col0) const {
        if (col0 < 1024) {
#pragma unroll
            for (int m = 0; m < 4; ++m)
#pragma unroll
                for (int n = 0; n < 4; ++n) { uint2 o; o.x = pk2(acc[n][m][0], acc[n][m][1]); o.y = pk2(acc[n][m][2], acc[n][m][3]);
                    *(uint2*)(Bg + (size_t)(row0 + 16 * m) * D + col0 + 16 * n) = o; }
        } else {
            const int pbase = (col0 - 1024) & ~63, jq = (col0 - 1024) & 15;
#pragma unroll
            for (int m = 0; m < 4; ++m)
#pragma unroll
                for (int n = 0; n < 4; n += 2) { const f32x4 v = acc[n][m] * acc[n + 1][m];
                    const int j = ((pbase >> 5) + (n >> 1)) * 16 + jq;
                    uint2 o; o.x = pk2(v[0], v[1]); o.y = pk2(v[2], v[3]);
                    *(uint2*)(Vv + (size_t)(row0 + 16 * m) * D + j) = o; }
        }
    }
};

template <class Epi>
__global__ void __launch_bounds__(256) k_gemm(const bf16_t* __restrict__ A, const bf16_t* __restrict__ Bt, Epi epi_in, int lda, int ldb, int K, int a_gs, int b_gs, int c_gs) {
    __shared__ __attribute__((aligned(16))) unsigned char lds[GEMM_LDS];
    Epi epi = epi_in;
    const int g = blockIdx.z;
    gemm_tile(A + (size_t)g * a_gs, lda, Bt + (size_t)g * b_gs, ldb, K, blockIdx.y * 128, blockIdx.x * 128 + g * c_gs, epi, lds);
}

__global__ void __launch_bounds__(256) k_conv(const bf16_t* __restrict__ Bg, const bf16_t* __restrict__ Vv, const float* __restrict__ cw, bf16_t* __restrict__ Aa) {
    const size_t i = (size_t)blockIdx.x * 256 + threadIdx.x;
    const int t = (int)(i >> 8), c4 = (int)(i & 255), s = t & (SEQ - 1);
    const uint2 b = ((const uint2*)Bg)[i], v2 = ((const uint2*)Vv)[i];
    uint2 v1 = make_uint2(0, 0), v0 = make_uint2(0, 0);
    if (s >= 1) v1 = ((const uint2*)Vv)[i - 256];
    if (s >= 2) v0 = ((const uint2*)Vv)[i - 512];
    const float4 w0 = ((const float4*)cw)[c4], w1 = ((const float4*)(cw + D))[c4], w2 = ((const float4*)(cw + 2 * D))[c4];
    float r0 = bf_lo(b.x) * (w0.x * bf_lo(v0.x) + w1.x * bf_lo(v1.x) + w2.x * bf_lo(v2.x));
    float r1 = bf_hi(b.x) * (w0.y * bf_hi(v0.x) + w1.y * bf_hi(v1.x) + w2.y * bf_hi(v2.x));
    float r2 = bf_lo(b.y) * (w0.z * bf_lo(v0.y) + w1.z * bf_lo(v1.y) + w2.z * bf_lo(v2.y));
    float r3 = bf_hi(b.y) * (w0.w * bf_hi(v0.y) + w1.w * bf_hi(v1.y) + w2.w * bf_hi(v2.y));
    uint2 o; o.x = pk2(r0, r1); o.y = pk2(r2, r3);
    ((uint2*)Aa)[i] = o;
}
__global__ void __launch_bounds__(256) k_pool(const bf16_t* __restrict__ Uu, bf16_t* __restrict__ Pp) {
    const size_t i = (size_t)blockIdx.x * 256 + threadIdx.x;
    const int t = (int)(i >> 8), c4 = (int)(i & 255), s = t & (SEQ - 1);
    const int w = 2 << (c4 >> 6);
    const int cnt = (s + 1 < w) ? s + 1 : w;
    float a0 = 0.f, a1 = 0.f, a2 = 0.f, a3 = 0.f;
    const uint2 cur = ((const uint2*)Uu)[i];
    for (int k = 0; k < cnt; ++k) { const uint2 v = ((const uint2*)Uu)[i - (size_t)k * 256]; a0 += bf_lo(v.x); a1 += bf_hi(v.x); a2 += bf_lo(v.y); a3 += bf_hi(v.y); }
    const float inv = 1.0f / (float)cnt;
    uint2 o; o.x = pk2(a0 * inv - bf_lo(cur.x), a1 * inv - bf_hi(cur.x)); o.y = pk2(a2 * inv - bf_lo(cur.y), a3 * inv - bf_hi(cur.y));
    ((uint2*)Pp)[i] = o;
}

__device__ __forceinline__ int ord_key(float f) { const int b = __builtin_bit_cast(int, f); return b >= 0 ? b : (b ^ 0x7fffffff); }
__device__ __forceinline__ float key_val(int k) { const int b = k >= 0 ? k : (k ^ 0x7fffffff); return __builtin_bit_cast(float, b); }
__device__ __forceinline__ void ce(int& hi, int& lo) { const int a = hi, b = lo; hi = a > b ? a : b; lo = a > b ? b : a; }
__device__ __forceinline__ void sort16_desc(int (&v)[16]) {
#pragma unroll
    for (int ks = 1; ks <= 4; ++ks)
#pragma unroll
        for (int js = ks - 1; js >= 0; --js)
#pragma unroll
            for (int i = 0; i < 16; ++i) { const int k = 1 << ks, j = 1 << js, l = i ^ j; if (l > i) { if ((i & k) == 0) ce(v[i], v[l]); else ce(v[l], v[i]); } }
}
__device__ __forceinline__ void merge16_desc(int (&a)[16], const int (&b)[16]) {
#pragma unroll
    for (int i = 0; i < 16; ++i) a[i] = a[i] > b[15 - i] ? a[i] : b[15 - i];
#pragma unroll
    for (int js = 3; js >= 0; --js)
#pragma unroll
        for (int i = 0; i < 16; ++i) { const int j = 1 << js, l = i ^ j; if (l > i) ce(a[i], a[l]); }
}
__host__ __device__ constexpr int cand_ij(int c) { int n = 0; for (int i = 0; i < 16; ++i) for (int j = 0; j < 16; ++j) if ((i + 1) * (j + 1) <= 16) { if (n == c) return i * 16 + j; ++n; } return -1; }
constexpr int NCAND = 50;
static_assert(cand_ij(NCAND - 1) >= 0 && cand_ij(NCAND) < 0, "candidate count");
template <int C> __device__ __forceinline__ void cand_step(const float (&v1)[16], const float (&v2)[16], int (&cur)[16], int (&run)[16]) {
    constexpr int ij = cand_ij(C), i = ij >> 4, j = ij & 15;
    cur[C & 15] = (ord_key(v1[i] + v2[j]) & ~255) | ij;
    if constexpr ((C & 15) == 15 || C == NCAND - 1) {
        if constexpr (C == NCAND - 1) {
#pragma unroll
            for (int q = (C & 15) + 1; q < 16; ++q) cur[q] = (int)0x80000000;
        }
        sort16_desc(cur);
        if constexpr (C == 15) {
#pragma unroll
            for (int q = 0; q < 16; ++q) run[q] = cur[q];
        } else merge16_desc(run, cur);
    }
}
template <int... C> __device__ __forceinline__ void cand_all(std::integer_sequence<int, C...>, const float (&v1)[16], const float (&v2)[16], int (&cur)[16], int (&run)[16]) { (cand_step<C>(v1, v2, cur, run), ...); }
__device__ __forceinline__ void top16_of_128(const float* __restrict__ s, int (&run)[16]) {
#pragma unroll 1
    for (int g = 0; g < 8; ++g) {
        int cur[16];
#pragma unroll
        for (int q = 0; q < 4; ++q) { const float4 v = ((const float4*)s)[g * 4 + q];
            cur[4 * q + 0] = (ord_key(v.x) & ~127) | (g * 16 + 4 * q + 0); cur[4 * q + 1] = (ord_key(v.y) & ~127) | (g * 16 + 4 * q + 1);
            cur[4 * q + 2] = (ord_key(v.z) & ~127) | (g * 16 + 4 * q + 2); cur[4 * q + 3] = (ord_key(v.w) & ~127) | (g * 16 + 4 * q + 3); }
        sort16_desc(cur);
        if (g == 0) {
#pragma unroll
            for (int i = 0; i < 16; ++i) run[i] = cur[i];
        } else merge16_desc(run, cur);
    }
}
__device__ __forceinline__ int lut16(const int (&p)[4], int i) {
    const int r = i >> 2; const int w = r == 0 ? p[0] : (r == 1 ? p[1] : (r == 2 ? p[2] : p[3]));
    return (w >> ((i & 3) * 8)) & 127;
}
__global__ void __launch_bounds__(64) k_topk(const float* __restrict__ S1, const float* __restrict__ S2, int* __restrict__ IDX, float* __restrict__ GATE) {
    const size_t p = (size_t)blockIdx.x * 64 + threadIdx.x;
    int k1[16], k2[16];
    top16_of_128(S1 + p * 128, k1);
    top16_of_128(S2 + p * 128, k2);
    float v1[16], v2[16]; int id1[4] = {0, 0, 0, 0}, id2[4] = {0, 0, 0, 0};
#pragma unroll
    for (int i = 0; i < 16; ++i) { v1[i] = key_val(k1[i] & ~127); v2[i] = key_val(k2[i] & ~127); id1[i >> 2] |= (k1[i] & 127) << ((i & 3) * 8); id2[i >> 2] |= (k2[i] & 127) << ((i & 3) * 8); }
    int run[16];
    { int cur[16]; cand_all(std::make_integer_sequence<int, NCAND>{}, v1, v2, cur, run); }
    float sc[16], e[16], sum = 0.f;
#pragma unroll
    for (int i = 0; i < 16; ++i) sc[i] = key_val(run[i] & ~255);
#pragma unroll
    for (int i = 0; i < 16; ++i) { e[i] = __expf(sc[i] - sc[0]); sum += e[i]; }
    const float inv = 1.0f / sum;
    int* io = IDX + p * 16; float* go = GATE + p * 16;
#pragma unroll
    for (int q = 0; q < 4; ++q) {
        int4 iv; float4 gv;
        { const int f = run[4 * q + 0] & 255; iv.x = lut16(id1, f >> 4) * 128 + lut16(id2, f & 15); gv.x = e[4 * q + 0] * inv; }
        { const int f = run[4 * q + 1] & 255; iv.y = lut16(id1, f >> 4) * 128 + lut16(id2, f & 15); gv.y = e[4 * q + 1] * inv; }
        { const int f = run[4 * q + 2] & 255; iv.z = lut16(id1, f >> 4) * 128 + lut16(id2, f & 15); gv.z = e[4 * q + 2] * inv; }
        { const int f = run[4 * q + 3] & 255; iv.w = lut16(id1, f >> 4) * 128 + lut16(id2, f & 15); gv.w = e[4 * q + 3] * inv; }
        ((int4*)io)[q] = iv; ((float4*)go)[q] = gv;
    }
}

__global__ void __launch_bounds__(256) k_peer(const bf16_t* __restrict__ H2, const int* __restrict__ IDX, const float* __restrict__ GATE,
                                              const bf16_t* __restrict__ U, const bf16_t* __restrict__ V, const float* __restrict__ Xin, const float* __restrict__ g2, float* __restrict__ Xout) {
    __shared__ float wl[NSEL];
    __shared__ int il[NSEL];
    const int t = blockIdx.x, lane = threadIdx.x & 63, wid = threadIdx.x >> 6, b = t / SEQ;
    if (threadIdx.x < NSEL) il[threadIdx.x] = IDX[(size_t)t * NSEL + threadIdx.x];
    const uint4 h0 = *(const uint4*)(H2 + (size_t)t * D + lane * 8), h1 = *(const uint4*)(H2 + (size_t)t * D + 512 + lane * 8);
    float hf[16];
    hf[0] = bf_lo(h0.x); hf[1] = bf_hi(h0.x); hf[2] = bf_lo(h0.y); hf[3] = bf_hi(h0.y); hf[4] = bf_lo(h0.z); hf[5] = bf_hi(h0.z); hf[6] = bf_lo(h0.w); hf[7] = bf_hi(h0.w);
    hf[8] = bf_lo(h1.x); hf[9] = bf_hi(h1.x); hf[10] = bf_lo(h1.y); hf[11] = bf_hi(h1.y); hf[12] = bf_lo(h1.z); hf[13] = bf_hi(h1.z); hf[14] = bf_lo(h1.w); hf[15] = bf_hi(h1.w);
    __syncthreads();
#pragma unroll 4
    for (int e = 0; e < 32; ++e) {
        const int id = il[wid * 32 + e];
        const bf16_t* row = U + (size_t)id * D;
        const uint4 r0 = *(const uint4*)(row + lane * 8), r1 = *(const uint4*)(row + 512 + lane * 8);
        float d = hf[0] * bf_lo(r0.x) + hf[1] * bf_hi(r0.x) + hf[2] * bf_lo(r0.y) + hf[3] * bf_hi(r0.y) + hf[4] * bf_lo(r0.z) + hf[5] * bf_hi(r0.z) + hf[6] * bf_lo(r0.w) + hf[7] * bf_hi(r0.w)
                + hf[8] * bf_lo(r1.x) + hf[9] * bf_hi(r1.x) + hf[10] * bf_lo(r1.y) + hf[11] * bf_hi(r1.y) + hf[12] * bf_lo(r1.z) + hf[13] * bf_hi(r1.z) + hf[14] * bf_lo(r1.w) + hf[15] * bf_hi(r1.w);
        d = wave_sum(d);
        if (lane == 0) { const float ge = 0.5f * d * (1.0f + erff(d * 0.70710678118654752f)); wl[wid * 32 + e] = GATE[(size_t)t * NSEL + wid * 32 + e] * ge; }
    }
    __syncthreads();
    float a0 = 0.f, a1 = 0.f, a2 = 0.f, a3 = 0.f;
    const int col = wid * 256 + lane * 4;
#pragma unroll 8
    for (int e = 0; e < NSEL; ++e) {
        const uint2 r = *(const uint2*)(V + (size_t)il[e] * D + col); const float w = wl[e];
        a0 += w * bf_lo(r.x); a1 += w * bf_hi(r.x); a2 += w * bf_lo(r.y); a3 += w * bf_hi(r.y);
    }
    const float4 xi = *(const float4*)(Xin + (size_t)t * D + col), g = *(const float4*)(g2 + (size_t)b * 6144 + col);
    float4 o; o.x = xi.x + g.x * a0; o.y = xi.y + g.y * a1; o.z = xi.z + g.z * a2; o.w = xi.w + g.w * a3;
    *(float4*)(Xout + (size_t)t * D + col) = o;
}

static size_t al(size_t x) { return (x + 255) & ~(size_t)255; }
extern "C" void kernel_launch(void* const* d_in, const int* in_sizes, int n_in, void* d_out, int out_size, void* d_ws, size_t ws_size, hipStream_t stream) {
    const float* x = (const float*)d_in[0];      const float* c = (const float*)d_in[1];
    const float* norm1_g = (const float*)d_in[2]; const float* norm2_g = (const float*)d_in[3];
    const float* w_mod = (const float*)d_in[4];  const float* b_mod = (const float*)d_in[5];
    const float* conv_w_in = (const float*)d_in[6]; const float* conv_w = (const float*)d_in[7]; const float* conv_w_out = (const float*)d_in[8];
    const float* pool_w_in = (const float*)d_in[9]; const float* pool_w_grp = (const float*)d_in[10]; const float* pool_scale = (const float*)d_in[11]; const float* pool_w_out = (const float*)d_in[12];
    const float* peer_w_q = (const float*)d_in[13]; const float* peer_k1 = (const float*)d_in[14]; const float* peer_k2 = (const float*)d_in[15];
    const float* peer_u = (const float*)d_in[16]; const float* peer_v = (const float*)d_in[17]; const float* final_g = (const float*)d_in[18];
    float* out = (float*)d_out;

    unsigned char* ws = (unsigned char*)d_ws; size_t off = 0;
    auto take = [&](size_t bytes) { unsigned char* p = ws + off; off += al(bytes); return p; };
    bf16_t* U16 = (bf16_t*)take((size_t)2 * NE * D * 2);
    bf16_t* V16 = (bf16_t*)take((size_t)2 * NE * D * 2);
    bf16_t* Wci = (bf16_t*)take((size_t)3072 * D * 2);
    bf16_t* Wco = (bf16_t*)take((size_t)D * D * 2);
    bf16_t* Wpi = (bf16_t*)take((size_t)D * D * 2);
    bf16_t* Wpg = (bf16_t*)take((size_t)4 * 256 * 256 * 2);
    bf16_t* Wpo = (bf16_t*)take((size_t)D * D * 2);
    bf16_t* Wq  = (bf16_t*)take((size_t)2 * 2048 * D * 2);
    bf16_t* K1  = (bf16_t*)take((size_t)2 * 128 * 128 * 2);
    bf16_t* K2  = (bf16_t*)take((size_t)2 * 128 * 128 * 2);
    float* modp = (float*)take((size_t)2 * 8 * 8 * 6144 * 4);
    float* mod  = (float*)take((size_t)2 * 8 * 6144 * 4);
    bf16_t* Hh = (bf16_t*)take((size_t)T * D * 2);
    bf16_t* Bg = (bf16_t*)take((size_t)T * D * 2);
    bf16_t* Vv = (bf16_t*)take((size_t)T * D * 2);
    bf16_t* Aa = (bf16_t*)take((size_t)T * D * 2);
    float* S1 = (float*)Hh; float* S2 = S1 + (size_t)T * 8 * 128;
    float* XA = (float*)take((size_t)T * D * 4);
    bf16_t* H2 = (bf16_t*)take((size_t)T * D * 2);
    bf16_t* Qq = (bf16_t*)take((size_t)T * 2048 * 2);
    int* IDX = (int*)take((size_t)T * NSEL * 4);
    float* GATE = (float*)take((size_t)T * NSEL * 4);
    if (off > ws_size) { fprintf(stderr, "kernel_launch: workspace too small: need %zu, have %zu\n", off, ws_size); return; }
    float* XB = out;

    k_cvt<<<2048, 256, 0, stream>>>(peer_u, U16, (size_t)2 * NE * D / 8);
    k_cvt<<<2048, 256, 0, stream>>>(peer_v, V16, (size_t)2 * NE * D / 8);
    k_cvt<<<64, 256, 0, stream>>>(peer_k1, K1, (size_t)2 * 128 * 128 / 8);
    k_cvt<<<64, 256, 0, stream>>>(peer_k2, K2, (size_t)2 * 128 * 128 / 8);
    k_transpose_cvt<1><<<dim3(3072 / 32, D / 32), 256, 0, stream>>>(conv_w_in, Wci, D, 3072);
    k_transpose_cvt<0><<<dim3(D / 32, D / 32), 256, 0, stream>>>(conv_w_out, Wco, D, D);
    k_transpose_cvt<0><<<dim3(D / 32, D / 32), 256, 0, stream>>>(pool_w_in, Wpi, D, D);
    for (int g = 0; g < 4; ++g) k_transpose_cvt<0><<<dim3(256 / 32, 256 / 32), 256, 0, stream>>>(pool_w_grp + (size_t)g * 65536, Wpg + (size_t)g * 65536, 256, 256);
    k_transpose_cvt<0><<<dim3(D / 32, D / 32), 256, 0, stream>>>(pool_w_out, Wpo, D, D);
    for (int l = 0; l < 2; ++l) k_transpose_cvt<0><<<dim3(2048 / 32, D / 32), 256, 0, stream>>>(peer_w_q + (size_t)l * D * 2048, Wq + (size_t)l * 2048 * D, D, 2048);
    k_mod_partial<<<dim3(6144 / 256, 8, 2), 256, 0, stream>>>(c, w_mod, modp);
    k_mod_reduce<<<2 * 8 * 6144 / 256, 256, 0, stream>>>(modp, b_mod, mod);

    const float* xin = x;
    for (int l = 0; l < 2; ++l) {
        const float* ml = mod + (size_t)l * 8 * 6144;
        float* x1 = XA; float* x2 = XB;
        k_rmsnorm<0><<<T / 4, 256, 0, stream>>>(xin, norm1_g + l * D, ml + 0, ml + 1024, Hh, nullptr);
        if (l == 0) {
            k_gemm<EpiConvIn><<<dim3(3072 / 128, T / 128, 1), 256, 0, stream>>>(Hh, Wci, EpiConvIn{Bg, Vv}, D, D, D, 0, 0, 0);
            k_conv<<<T * D / 4 / 256, 256, 0, stream>>>(Bg, Vv, conv_w, Aa);
            k_gemm<EpiResid><<<dim3(D / 128, T / 128, 1), 256, 0, stream>>>(Aa, Wco, EpiResid{xin, x1, ml + 2048}, D, D, D, 0, 0, 0);
        } else {
            k_gemm<EpiBf16><<<dim3(D / 128, T / 128, 1), 256, 0, stream>>>(Hh, Wpi, EpiBf16{Bg, D, 0}, D, D, D, 0, 0, 0);
            k_pool<<<T * D / 4 / 256, 256, 0, stream>>>(Bg, Vv);
            k_gemm<EpiScaleBf16><<<dim3(2, T / 128, 4), 256, 0, stream>>>(Vv, Wpg, EpiScaleBf16{Aa, pool_scale, D, 0}, D, 256, 256, 256, 0, 256);
            k_gemm<EpiResid><<<dim3(D / 128, T / 128, 1), 256, 0, stream>>>(Aa, Wpo, EpiResid{xin, x1, ml + 2048}, D, D, D, 0, 0, 0);
        }
        k_rmsnorm<0><<<T / 4, 256, 0, stream>>>(x1, norm2_g + l * D, ml + 3072, ml + 4096, H2, nullptr);
        k_gemm<EpiBf16><<<dim3(2048 / 128, T / 128, 1), 256, 0, stream>>>(H2, Wq + (size_t)l * 2048 * D, EpiBf16{Qq, 2048, 0}, D, D, D, 0, 0, 0);
        k_gemm<EpiF32><<<dim3(1, T * 8 / 128, 1), 256, 0, stream>>>(Qq, K1 + (size_t)l * 16384, EpiF32{S1, 128, 0}, 256, 128, 128, 0, 0, 0);
        k_gemm<EpiF32><<<dim3(1, T * 8 / 128, 1), 256, 0, stream>>>(Qq + 128, K2 + (size_t)l * 16384, EpiF32{S2, 128, 0}, 256, 128, 128, 0, 0, 0);
        k_topk<<<T * 8 / 64, 64, 0, stream>>>(S1, S2, IDX, GATE);
        k_peer<<<T, 256, 0, stream>>>(H2, IDX, GATE, U16 + (size_t)l * NE * D, V16 + (size_t)l * NE * D, x1, ml + 5120, x2);
        xin = x2;
    }
    k_rmsnorm<1><<<T / 4, 256, 0, stream>>>(XB, final_g, nullptr, nullptr, nullptr, XB);
}
```

```cpp
#include <hip/hip_runtime.h>
#include <cstdio>
#include <cstdint>
#include <utility>

typedef unsigned short bf16_t;
typedef short bf16x8 __attribute__((ext_vector_type(8)));
typedef float f32x4 __attribute__((ext_vector_type(4)));

constexpr int D = 1024, NB = 8, SEQ = 2048, T = NB * SEQ;
constexpr int NE = 16384, NH = 8, TOPK = 16, NSEL = NH * TOPK;
constexpr float EPS = 1e-6f;

__device__ __forceinline__ unsigned f2bf(float f) { unsigned u = __builtin_bit_cast(unsigned, f); return (u + 0x7fffu + ((u >> 16) & 1u)) >> 16; }
__device__ __forceinline__ unsigned pk2(float lo, float hi) { return f2bf(lo) | (f2bf(hi) << 16); }
__device__ __forceinline__ float bf_lo(unsigned u) { return __builtin_bit_cast(float, u << 16); }
__device__ __forceinline__ float bf_hi(unsigned u) { return __builtin_bit_cast(float, u & 0xffff0000u); }
__device__ __forceinline__ int otid() { int t = threadIdx.x; asm volatile("" : "+v"(t)); return t; }
__device__ __forceinline__ float wave_sum(float v) {
#pragma unroll
    for (int o = 32; o > 0; o >>= 1) v += __shfl_xor(v, o);
    return v;
}

#define XB_TMO      128
#define XB_XCNT(j)  (256  + 64 * (j))
#define XB_XSUB(j)  (1280 + 64 * (j))
#define XB_XGEN(j)  (2304 + 64 * (j))
#define XB_TOP      3328
#define XB_TOPGEN   3392
#define XCD_BAR_WORDS 3456
#define XB_SPIN_CAP (1u << 18)
#define LAS __attribute__((address_space(3)))
__device__ __forceinline__ unsigned xb_ld(unsigned* p)              { return __hip_atomic_load(p, __ATOMIC_RELAXED, __HIP_MEMORY_SCOPE_AGENT); }
__device__ __forceinline__ unsigned xb_add(unsigned* p, unsigned v) { return __hip_atomic_fetch_add(p, v, __ATOMIC_RELAXED, __HIP_MEMORY_SCOPE_AGENT); }
__device__ __forceinline__ unsigned xb_xcc_id() { return (unsigned)__builtin_amdgcn_s_getreg((3 << 11) | 20) & 0xFu; }
#define XB_SPIN(cond, bar) do { unsigned _sp = 0; while (cond) { __builtin_amdgcn_s_sleep(1); \
    if ((++_sp & 255u) == 0u) { if (xb_ld(&(bar)[XB_TMO])) break; if (_sp > XB_SPIN_CAP) { atomicAdd(&(bar)[XB_TMO], 1u); break; } } } } while (0)
struct XcdBarrier { unsigned* bar; unsigned x; volatile LAS unsigned* st; };
__device__ __forceinline__ XcdBarrier xcd_barrier_post(unsigned* bar, volatile LAS unsigned* st) {
    XcdBarrier b; b.bar = bar; b.x = xb_xcc_id(); b.st = st;
    if (threadIdx.x == 0) (void)xb_add(&bar[XB_XCNT(b.x)], 1u);
    return b;
}
__device__ __forceinline__ void xcd_barrier_complete(unsigned* bar, unsigned x, unsigned& nloc, unsigned& nx) {
    const unsigned G = gridDim.x * gridDim.y * gridDim.z;
    unsigned sum, cnt, mine, sp = 0u;
    for (;;) {
        sum = 0u; cnt = 0u; mine = 0u;
#pragma unroll
        for (unsigned j = 0; j < 16; ++j) { const unsigned c = xb_ld(&bar[XB_XCNT(j)]); sum += c; cnt += (c > 0u) ? 1u : 0u; mine = (j == x) ? c : mine; }
        if (sum == G) break;
        __builtin_amdgcn_s_sleep(1);
        if ((++sp & 255u) == 0u) { if (xb_ld(&bar[XB_TMO])) break; if (sp > XB_SPIN_CAP) { atomicAdd(&bar[XB_TMO], 1u); break; } }
    }
    nloc = mine > 0u ? mine : 1u; nx = cnt > 0u ? cnt : 1u;
}
__device__ __forceinline__ void xcd_barrier(const XcdBarrier& b) {
    asm volatile("s_waitcnt vmcnt(0)" ::: "memory");
    __syncthreads();
    if (threadIdx.x == 0) {
        unsigned* bar = b.bar;
        __builtin_amdgcn_s_waitcnt(0);
        unsigned nloc = b.st[0], nx = b.st[1];
        if (nloc == 0u) { xcd_barrier_complete(bar, b.x, nloc, nx); b.st[0] = nloc; b.st[1] = nx; }
        const unsigned old = xb_add(&bar[XB_XSUB(b.x)], 1u);
        const unsigned gen = old / nloc;
        if (old + 1u == (gen + 1u) * nloc) {
            __builtin_amdgcn_fence(__ATOMIC_RELEASE, "agent");
            asm volatile("s_waitcnt vmcnt(0)" ::: "memory");
            const unsigned og = xb_add(&bar[XB_TOP], 1u);
            const unsigned tg = og / nx;
            if (og + 1u == (tg + 1u) * nx) xb_add(&bar[XB_TOPGEN], 1u);
            else XB_SPIN(xb_ld(&bar[XB_TOPGEN]) == tg, bar);
            __builtin_amdgcn_fence(__ATOMIC_ACQUIRE, "agent");
            xb_add(&bar[XB_XGEN(b.x)], 1u);
            asm volatile("s_waitcnt vmcnt(0)" ::: "memory");
        } else {
            XB_SPIN(xb_ld(&bar[XB_XGEN(b.x)]) == gen, bar);
            __builtin_amdgcn_fence(__ATOMIC_ACQUIRE, "agent");
            asm volatile("s_waitcnt vmcnt(0)" ::: "memory");
        }
    }
    __syncthreads();
}

constexpr int GEMM_LDS = 65536;
template <class Epi>
__device__ __forceinline__ void gemm_tile(const bf16_t* __restrict__ A, int lda, const bf16_t* __restrict__ Bt, int ldb, int K, int m0, int n0, const Epi& epi, unsigned char* lds) {
    const int tid = otid(), lane = tid & 63, wid = tid >> 6, wr = wid >> 1, wc = wid & 1;
    const int fr = lane & 15, fq = lane >> 4;
    f32x4 acc[4][4];
#pragma unroll
    for (int n = 0; n < 4; ++n)
#pragma unroll
        for (int m = 0; m < 4; ++m) acc[n][m] = (f32x4){0.f, 0.f, 0.f, 0.f};
    uint4 ra[4], rb[4];
    const int srow = tid >> 3, sch = tid & 7;
    const bf16_t* ag = A + (size_t)(m0 + srow) * lda + sch * 8;
    const bf16_t* bg = Bt + (size_t)(n0 + srow) * ldb + sch * 8;
    const int soff = srow * 128 + ((sch ^ (srow & 7)) << 4);
    const int nk = K >> 6;
#pragma unroll
    for (int i = 0; i < 4; ++i) { ra[i] = *(const uint4*)(ag + (size_t)(32 * i) * lda); rb[i] = *(const uint4*)(bg + (size_t)(32 * i) * ldb); }
#pragma unroll
    for (int i = 0; i < 4; ++i) { *(uint4*)(lds + soff + i * 4096) = ra[i]; *(uint4*)(lds + 16384 + soff + i * 4096) = rb[i]; }
    __syncthreads();
    for (int kt = 0; kt < nk; ++kt) {
        unsigned char* cur = lds + (kt & 1) * 32768;
        unsigned char* nxt = lds + ((kt + 1) & 1) * 32768;
        const int kn = (kt + 1 < nk ? kt + 1 : kt) * 64;
#pragma unroll
        for (int i = 0; i < 4; ++i) { ra[i] = *(const uint4*)(ag + (size_t)(32 * i) * lda + kn); rb[i] = *(const uint4*)(bg + (size_t)(32 * i) * ldb + kn); }
#pragma unroll
        for (int ks = 0; ks < 2; ++ks) {
            bf16x8 af[4], bf[4];
#pragma unroll
            for (int m = 0; m < 4; ++m) { const int row = wr * 64 + m * 16 + fr; af[m] = *(const bf16x8*)(cur + row * 128 + (((ks * 4 + fq) ^ (row & 7)) << 4)); }
#pragma unroll
            for (int n = 0; n < 4; ++n) { const int row = wc * 64 + n * 16 + fr; bf[n] = *(const bf16x8*)(cur + 16384 + row * 128 + (((ks * 4 + fq) ^ (row & 7)) << 4)); }
#pragma unroll
            for (int n = 0; n < 4; ++n)
#pragma unroll
                for (int m = 0; m < 4; ++m) acc[n][m] = __builtin_amdgcn_mfma_f32_16x16x32_bf16(bf[n], af[m], acc[n][m], 0, 0, 0);
        }
#pragma unroll
        for (int i = 0; i < 4; ++i) { *(uint4*)(nxt + soff + i * 4096) = ra[i]; *(uint4*)(nxt + 16384 + soff + i * 4096) = rb[i]; }
        __syncthreads();
    }
    epi(acc, m0 + wr * 64 + fr, n0 + wc * 64 + fq * 4);
}

struct EpiBf16 {
    bf16_t* O; int ldc; int pad;
    __device__ __forceinline__ void operator()(const f32x4 (&acc)[4][4], int row0, int col0) const {
#pragma unroll
        for (int m = 0; m < 4; ++m)
#pragma unroll
            for (int n = 0; n < 4; ++n) { uint2 o; o.x = pk2(acc[n][m][0], acc[n][m][1]); o.y = pk2(acc[n][m][2], acc[n][m][3]);
                *(uint2*)(O + (size_t)(row0 + 16 * m) * ldc + col0 + 16 * n) = o; }
    }
};
struct EpiF32 {
    float* O; int ldc; int pad;
    __device__ __forceinline__ void operator()(const f32x4 (&acc)[4][4], int row0, int col0) const {
#pragma unroll
        for (int m = 0; m < 4; ++m)
#pragma unroll
            for (int n = 0; n < 4; ++n) *(f32x4*)(O + (size_t)(row0 + 16 * m) * ldc + col0 + 16 * n) = acc[n][m];
    }
};
struct EpiScaleBf16 {
    bf16_t* O; const float* scale; int ldc; int pad;
    __device__ __forceinline__ void operator()(const f32x4 (&acc)[4][4], int row0, int col0) const {
#pragma unroll
        for (int n = 0; n < 4; ++n) { const f32x4 s = *(const f32x4*)(scale + col0 + 16 * n);
#pragma unroll
            for (int m = 0; m < 4; ++m) { const f32x4 v = acc[n][m] * s; uint2 o; o.x = pk2(v[0], v[1]); o.y = pk2(v[2], v[3]);
                *(uint2*)(O + (size_t)(row0 + 16 * m) * ldc + col0 + 16 * n) = o; } }
    }
};
struct EpiResid {
    const float* Xin; float* Xout; const float* gate;
    __device__ __forceinline__ void operator()(const f32x4 (&acc)[4][4], int row0, int col0) const {
#pragma unroll
        for (int m = 0; m < 4; ++m) { const int row = row0 + 16 * m, b = row / SEQ;
#pragma unroll
            for (int n = 0; n < 4; ++n) { const int col = col0 + 16 * n;
                const f32x4 xi = *(const f32x4*)(Xin + (size_t)row * D + col), g = *(const f32x4*)(gate + (size_t)b * 6144 + col);
                *(f32x4*)(Xout + (size_t)row * D + col) = xi + g * acc[n][m]; } }
    }
};
struct EpiConvIn {
    bf16_t* Bg; bf16_t* Vv;
    __device__ __forceinline__ void operator()(const f32x4 (&acc)[4][4], int row0, int col0) const {
        if (col0 < 1024) {
#pragma unroll
            for (int m = 0; m < 4; ++m)
#pragma unroll
                for (int n = 0; n < 4; ++n) { uint2 o; o.x = pk2(acc[n][m][0], acc[n][m][1]); o.y = pk2(acc[n][m][2], acc[n][m][3]);
                    *(uint2*)(Bg + (size_t)(row0 + 16 * m) * D + col0 + 16 * n) = o; }
        } else {
            const int pbase = (col0 - 1024) & ~63, jq = (col0 - 1024) & 15;
#pragma unroll
            for (int m = 0; m < 4; ++m)
#pragma unroll
                for (int n = 0; n < 4; n += 2) { const f32x4 v = acc[n][m] * acc[n + 1][m];
                    const int j = ((pbase >> 5) + (n >> 1)) * 16 + jq;
                    uint2 o; o.x = pk2(v[0], v[1]); o.y = pk2(v[2], v[3]);
                    *(uint2*)(Vv + (size_t)(row0 + 16 * m) * D + j) = o; }
        }
    }
};

__device__ __forceinline__ int ord_key(float f) { const int b = __builtin_bit_cast(int, f); return b >= 0 ? b : (b ^ 0x7fffffff); }
__device__ __forceinline__ float key_val(int k) { const int b = k >= 0 ? k : (k ^ 0x7fffffff); return __builtin_bit_cast(float, b); }
__device__ __forceinline__ void ce(int& hi, int& lo) { const int a = hi, b = lo; hi = a > b ? a : b; lo = a > b ? b : a; }
__device__ __forceinline__ void sort16_desc(int (&v)[16]) {
#pragma unroll
    for (int ks = 1; ks <= 4; ++ks)
#pragma unroll
        for (int js = ks - 1; js >= 0; --js)
#pragma unroll
            for (int i = 0; i < 16; ++i) { const int k = 1 << ks, j = 1 << js, l = i ^ j; if (l > i) { if ((i & k) == 0) ce(v[i], v[l]); else ce(v[l], v[i]); } }
}
__device__ __forceinline__ void merge16_desc(int (&a)[16], const int (&b)[16]) {
#pragma unroll
    for (int i = 0; i < 16; ++i) a[i] = a[i] > b[15 - i] ? a[i] : b[15 - i];
#pragma unroll
    for (int js = 3; js >= 0; --js)
#pragma unroll
        for (int i = 0; i < 16; ++i) { const int j = 1 << js, l = i ^ j; if (l > i) ce(a[i], a[l]); }
}
__host__ __device__ constexpr int cand_ij(int c) { int n = 0; for (int i = 0; i < 16; ++i) for (int j = 0; j < 16; ++j) if ((i + 1) * (j + 1) <= 16) { if (n == c) return i * 16 + j; ++n; } return -1; }
constexpr int NCAND = 50;
static_assert(cand_ij(NCAND - 1) >= 0 && cand_ij(NCAND) < 0, "candidate count");
template <int C> __device__ __forceinline__ void cand_step(const float (&v1)[16], const float (&v2)[16], int (&cur)[16], int (&run)[16]) {
    constexpr int ij = cand_ij(C), i = ij >> 4, j = ij & 15;
    cur[C & 15] = (ord_key(v1[i] + v2[j]) & ~255) | ij;
    if constexpr ((C & 15) == 15 || C == NCAND - 1) {
        if constexpr (C == NCAND - 1) {
#pragma unroll
            for (int q = (C & 15) + 1; q < 16; ++q) cur[q] = (int)0x80000000;
        }
        sort16_desc(cur);
        if constexpr (C == 15) {
#pragma unroll
            for (int q = 0; q < 16; ++q) run[q] = cur[q];
        } else merge16_desc(run, cur);
    }
}
template <int... C> __device__ __forceinline__ void cand_all(std::integer_sequence<int, C...>, const float (&v1)[16], const float (&v2)[16], int (&cur)[16], int (&run)[16]) { (cand_step<C>(v1, v2, cur, run), ...); }
__device__ __forceinline__ void top16_of_128(const float* __restrict__ s, int (&run)[16]) {
#pragma unroll 1
    for (int g = 0; g < 8; ++g) {
        int cur[16];
#pragma unroll
        for (int q = 0; q < 4; ++q) { const float4 v = ((const float4*)s)[g * 4 + q];
            cur[4 * q + 0] = (ord_key(v.x) & ~127) | (g * 16 + 4 * q + 0); cur[4 * q + 1] = (ord_key(v.y) & ~127) | (g * 16 + 4 * q + 1);
            cur[4 * q + 2] = (ord_key(v.z) & ~127) | (g * 16 + 4 * q + 2); cur[4 * q + 3] = (ord_key(v.w) & ~127) | (g * 16 + 4 * q + 3); }
        sort16_desc(cur);
        if (g == 0) {
#pragma unroll
            for (int i = 0; i < 16; ++i) run[i] = cur[i];
        } else merge16_desc(run, cur);
    }
}
__device__ __forceinline__ int lut16(const int (&p)[4], int i) {
    const int r = i >> 2; const int w = r == 0 ? p[0] : (r == 1 ? p[1] : (r == 2 ? p[2] : p[3]));
    return (w >> ((i & 3) * 8)) & 127;
}
constexpr size_t al256(size_t x) { return (x + 255) & ~(size_t)255; }
constexpr size_t WS_CTL  = 0;
constexpr size_t WS_U16  = al256(WS_CTL + 16384);
constexpr size_t WS_V16  = WS_U16 + (size_t)2 * NE * D * 2;
constexpr size_t WS_WCI  = WS_V16 + (size_t)2 * NE * D * 2;
constexpr size_t WS_WCO  = WS_WCI + (size_t)3072 * D * 2;
constexpr size_t WS_WPI  = WS_WCO + (size_t)D * D * 2;
constexpr size_t WS_WPG  = WS_WPI + (size_t)D * D * 2;
constexpr size_t WS_WPO  = WS_WPG + (size_t)4 * 256 * 256 * 2;
constexpr size_t WS_WQ   = WS_WPO + (size_t)D * D * 2;
constexpr size_t WS_K1   = WS_WQ + (size_t)2 * 2048 * D * 2;
constexpr size_t WS_K2   = WS_K1 + (size_t)2 * 128 * 128 * 2;
constexpr size_t WS_MOD  = WS_K2 + (size_t)2 * 128 * 128 * 2;
constexpr size_t WS_HH   = al256(WS_MOD + (size_t)2 * 8 * 6144 * 4);
constexpr size_t WS_BG   = WS_HH + (size_t)T * D * 2;
constexpr size_t WS_VV   = WS_BG + (size_t)T * D * 2;
constexpr size_t WS_AA   = WS_VV + (size_t)T * D * 2;
constexpr size_t WS_XA   = WS_AA + (size_t)T * D * 2;
constexpr size_t WS_H2   = WS_XA + (size_t)T * D * 4;
constexpr size_t WS_QQ   = WS_H2 + (size_t)T * D * 2;
constexpr size_t WS_IDX  = WS_QQ + (size_t)T * 2048 * 2;
constexpr size_t WS_GATE = WS_IDX + (size_t)T * NSEL * 4;
constexpr size_t WS_END  = WS_GATE + (size_t)T * NSEL * 4;

struct Params { const float* in[19]; float* out; unsigned char* ws; };

__device__ __forceinline__ int vblock() { const int G = gridDim.x; return ((G & 7) == 0) ? (int)((blockIdx.x & 7) * (G >> 3) + (blockIdx.x >> 3)) : (int)blockIdx.x; }

template <int MODE>
__device__ __forceinline__ void transpose_tile(const float* __restrict__ W, bf16_t* __restrict__ Wt, int K, int N, int tn, int tk, float* tile  ) {
    const int tid = otid(), n0 = tn * 64, k0 = tk * 64, tx = tid & 63, ty = tid >> 6;
#pragma unroll
    for (int i = 0; i < 16; ++i) tile[(ty + 4 * i) * 65 + tx] = W[(size_t)(k0 + ty + 4 * i) * N + n0 + tx];
    __syncthreads();
#pragma unroll
    for (int i = 0; i < 16; ++i) {
        int n = n0 + ty + 4 * i, p = n;
        if (MODE == 1 && n >= 1024) { const int j = (n - 1024) & 1023, isu = (n >= 2048); p = 1024 + (j >> 4) * 32 + isu * 16 + (j & 15); }
        Wt[(size_t)p * K + k0 + tx] = (bf16_t)f2bf(tile[tx * 65 + ty + 4 * i]);
    }
    __syncthreads();
}
__device__ __forceinline__ void cvt_chunk(const float* __restrict__ src, bf16_t* __restrict__ dst, size_t item) {
    const int tid = otid();
#pragma unroll
    for (int r = 0; r < 8; ++r) {
        const size_t i = item * 2048 + r * 256 + tid;
        const float4 a = ((const float4*)src)[2 * i], b = ((const float4*)src)[2 * i + 1];
        uint4 o; o.x = pk2(a.x, a.y); o.y = pk2(a.z, a.w); o.z = pk2(b.x, b.y); o.w = pk2(b.z, b.w);
        ((uint4*)dst)[i] = o;
    }
}
__device__ __forceinline__ void mod_item(const float* __restrict__ c, const float* __restrict__ w_mod, const float* __restrict__ b_mod, float* __restrict__ mod, int item, float* red  ) {
    const int tid = otid(), l = item / 96, n0 = (item % 96) * 64, col = tid & 63, kg = tid >> 6;
    float acc[8] = {0, 0, 0, 0, 0, 0, 0, 0};
    const float* w = w_mod + (size_t)l * D * 6144 + (size_t)(kg * 256) * 6144 + n0 + col;
#pragma unroll 4
    for (int k = 0; k < 256; ++k) { const float wv = w[(size_t)k * 6144];
#pragma unroll
        for (int b = 0; b < 8; ++b) { const float v = c[b * D + kg * 256 + k]; acc[b] += (v / (1.0f + __expf(-v))) * wv; } }
#pragma unroll
    for (int b = 0; b < 8; ++b) red[(kg * 8 + b) * 64 + col] = acc[b];
    __syncthreads();
    for (int i = tid; i < 512; i += 256) { const int b = i >> 6, cc = i & 63;
        mod[((size_t)l * 8 + b) * 6144 + n0 + cc] = b_mod[l * 6144 + n0 + cc] + red[(0 * 8 + b) * 64 + cc] + red[(1 * 8 + b) * 64 + cc] + red[(2 * 8 + b) * 64 + cc] + red[(3 * 8 + b) * 64 + cc]; }
    __syncthreads();
}

template <int MODE>
__device__ __forceinline__ void rmsnorm_row(const float* x, const float* __restrict__ g, const float* __restrict__ sh, const float* __restrict__ sc, bf16_t* ob, float* of, int row, int lane) {
    const int b = row / SEQ;
    const float4* xr = (const float4*)(x + (size_t)row * D);
    float4 v[4]; float ss = 0.f;
#pragma unroll
    for (int i = 0; i < 4; ++i) { v[i] = xr[lane + 64 * i]; ss += v[i].x * v[i].x + v[i].y * v[i].y + v[i].z * v[i].z + v[i].w * v[i].w; }
    ss = wave_sum(ss);
    const float r = rsqrtf(ss * (1.0f / D) + EPS);
#pragma unroll
    for (int i = 0; i < 4; ++i) {
        const int c4 = lane + 64 * i; const float4 gg = ((const float4*)g)[c4];
        float4 y; y.x = v[i].x * r * gg.x; y.y = v[i].y * r * gg.y; y.z = v[i].z * r * gg.z; y.w = v[i].w * r * gg.w;
        if (MODE == 0) {
            const float4 s1 = ((const float4*)(sc + (size_t)b * 6144))[c4], s0 = ((const float4*)(sh + (size_t)b * 6144))[c4];
            y.x = y.x * (1.f + s1.x) + s0.x; y.y = y.y * (1.f + s1.y) + s0.y; y.z = y.z * (1.f + s1.z) + s0.z; y.w = y.w * (1.f + s1.w) + s0.w;
            uint2 o; o.x = pk2(y.x, y.y); o.y = pk2(y.z, y.w);
            ((uint2*)(ob + (size_t)row * D))[c4] = o;
        } else ((float4*)(of + (size_t)row * D))[c4] = y;
    }
}

__device__ __forceinline__ void conv_elem(const bf16_t* __restrict__ Bg, const bf16_t* __restrict__ Vv, const float* __restrict__ cw, bf16_t* __restrict__ Aa, size_t i) {
    const int t = (int)(i >> 8), c4 = (int)(i & 255), s = t & (SEQ - 1);
    const uint2 b = ((const uint2*)Bg)[i], v2 = ((const uint2*)Vv)[i];
    uint2 v1 = make_uint2(0, 0), v0 = make_uint2(0, 0);
    if (s >= 1) v1 = ((const uint2*)Vv)[i - 256];
    if (s >= 2) v0 = ((const uint2*)Vv)[i - 512];
    const float4 w0 = ((const float4*)cw)[c4], w1 = ((const float4*)(cw + D))[c4], w2 = ((const float4*)(cw + 2 * D))[c4];
    const float r0 = bf_lo(b.x) * (w0.x * bf_lo(v0.x) + w1.x * bf_lo(v1.x) + w2.x * bf_lo(v2.x));
    const float r1 = bf_hi(b.x) * (w0.y * bf_hi(v0.x) + w1.y * bf_hi(v1.x) + w2.y * bf_hi(v2.x));
    const float r2 = bf_lo(b.y) * (w0.z * bf_lo(v0.y) + w1.z * bf_lo(v1.y) + w2.z * bf_lo(v2.y));
    const float r3 = bf_hi(b.y) * (w0.w * bf_hi(v0.y) + w1.w * bf_hi(v1.y) + w2.w * bf_hi(v2.y));
    uint2 o; o.x = pk2(r0, r1); o.y = pk2(r2, r3);
    ((uint2*)Aa)[i] = o;
}
__device__ __forceinline__ void pool_elem(const bf16_t* __restrict__ Uu, bf16_t* __restrict__ Pp, size_t i) {
    const int t = (int)(i >> 8), c4 = (int)(i & 255), s = t & (SEQ - 1);
    const int w = 2 << (c4 >> 6);
    const int cnt = (s + 1 < w) ? s + 1 : w;
    float a0 = 0.f, a1 = 0.f, a2 = 0.f, a3 = 0.f;
    const uint2 cur = ((const uint2*)Uu)[i];
    for (int k = 0; k < cnt; ++k) { const uint2 v = ((const uint2*)Uu)[i - (size_t)k * 256]; a0 += bf_lo(v.x); a1 += bf_hi(v.x); a2 += bf_lo(v.y); a3 += bf_hi(v.y); }
    const float inv = 1.0f / (float)cnt;
    uint2 o; o.x = pk2(a0 * inv - bf_lo(cur.x), a1 * inv - bf_hi(cur.x)); o.y = pk2(a2 * inv - bf_lo(cur.y), a3 * inv - bf_hi(cur.y));
    ((uint2*)Pp)[i] = o;
}

__device__ __forceinline__ void topk_pair(const float* __restrict__ S1, const float* __restrict__ S2, int* __restrict__ IDX, float* __restrict__ GATE, size_t p) {
    int k1[16], k2[16];
    top16_of_128(S1 + p * 128, k1);
    top16_of_128(S2 + p * 128, k2);
    float v1[16], v2[16]; int id1[4] = {0, 0, 0, 0}, id2[4] = {0, 0, 0, 0};
#pragma unroll
    for (int i = 0; i < 16; ++i) { v1[i] = key_val(k1[i] & ~127); v2[i] = key_val(k2[i] & ~127); id1[i >> 2] |= (k1[i] & 127) << ((i & 3) * 8); id2[i >> 2] |= (k2[i] & 127) << ((i & 3) * 8); }
    int run[16];
    { int cur[16]; cand_all(std::make_integer_sequence<int, NCAND>{}, v1, v2, cur, run); }
    float sc[16], e[16], sum = 0.f;
#pragma unroll
    for (int i = 0; i < 16; ++i) sc[i] = key_val(run[i] & ~255);
#pragma unroll
    for (int i = 0; i < 16; ++i) { e[i] = __expf(sc[i] - sc[0]); sum += e[i]; }
    const float inv = 1.0f / sum;
    int* io = IDX + p * 16; float* go = GATE + p * 16;
#pragma unroll
    for (int q = 0; q < 4; ++q) {
        int4 iv; float4 gv;
        { const int f = run[4 * q + 0] & 255; iv.x = lut16(id1, f >> 4) * 128 + lut16(id2, f & 15); gv.x = e[4 * q + 0] * inv; }
        { const int f = run[4 * q + 1] & 255; iv.y = lut16(id1, f >> 4) * 128 + lut16(id2, f & 15); gv.y = e[4 * q + 1] * inv; }
        { const int f = run[4 * q + 2] & 255; iv.z = lut16(id1, f >> 4) * 128 + lut16(id2, f & 15); gv.z = e[4 * q + 2] * inv; }
        { const int f = run[4 * q + 3] & 255; iv.w = lut16(id1, f >> 4) * 128 + lut16(id2, f & 15); gv.w = e[4 * q + 3] * inv; }
        ((int4*)io)[q] = iv; ((float4*)go)[q] = gv;
    }
}

__device__ __forceinline__ void peer_token(const bf16_t* __restrict__ H2, const int* __restrict__ IDX, const float* __restrict__ GATE, const bf16_t* __restrict__ U, const bf16_t* __restrict__ V,
                                           const float* __restrict__ Xin, const float* __restrict__ g2, float* __restrict__ Xout, int t, float* wl, int* il) {
    const int tid = otid(), lane = tid & 63, wid = tid >> 6, b = t / SEQ;
    if (tid < NSEL) il[tid] = IDX[(size_t)t * NSEL + tid];
    const uint4 h0 = *(const uint4*)(H2 + (size_t)t * D + lane * 8), h1 = *(const uint4*)(H2 + (size_t)t * D + 512 + lane * 8);
    float hf[16];
    hf[0] = bf_lo(h0.x); hf[1] = bf_hi(h0.x); hf[2] = bf_lo(h0.y); hf[3] = bf_hi(h0.y); hf[4] = bf_lo(h0.z); hf[5] = bf_hi(h0.z); hf[6] = bf_lo(h0.w); hf[7] = bf_hi(h0.w);
    hf[8] = bf_lo(h1.x); hf[9] = bf_hi(h1.x); hf[10] = bf_lo(h1.y); hf[11] = bf_hi(h1.y); hf[12] = bf_lo(h1.z); hf[13] = bf_hi(h1.z); hf[14] = bf_lo(h1.w); hf[15] = bf_hi(h1.w);
    __syncthreads();
#pragma unroll 4
    for (int e = 0; e < 32; ++e) {
        const int id = il[wid * 32 + e];
        const bf16_t* row = U + (size_t)id * D;
        const uint4 r0 = *(const uint4*)(row + lane * 8), r1 = *(const uint4*)(row + 512 + lane * 8);
        float d = hf[0] * bf_lo(r0.x) + hf[1] * bf_hi(r0.x) + hf[2] * bf_lo(r0.y) + hf[3] * bf_hi(r0.y) + hf[4] * bf_lo(r0.z) + hf[5] * bf_hi(r0.z) + hf[6] * bf_lo(r0.w) + hf[7] * bf_hi(r0.w)
                + hf[8] * bf_lo(r1.x) + hf[9] * bf_hi(r1.x) + hf[10] * bf_lo(r1.y) + hf[11] * bf_hi(r1.y) + hf[12] * bf_lo(r1.z) + hf[13] * bf_hi(r1.z) + hf[14] * bf_lo(r1.w) + hf[15] * bf_hi(r1.w);
        d = wave_sum(d);
        if (lane == 0) { const float ge = 0.5f * d * (1.0f + erff(d * 0.70710678118654752f)); wl[wid * 32 + e] = GATE[(size_t)t * NSEL + wid * 32 + e] * ge; }
    }
    __syncthreads();
    float a0 = 0.f, a1 = 0.f, a2 = 0.f, a3 = 0.f;
    const int col = wid * 256 + lane * 4;
#pragma unroll 8
    for (int e = 0; e < NSEL; ++e) {
        const uint2 r = *(const uint2*)(V + (size_t)il[e] * D + col); const float w = wl[e];
        a0 += w * bf_lo(r.x); a1 += w * bf_hi(r.x); a2 += w * bf_lo(r.y); a3 += w * bf_hi(r.y);
    }
    const float4 xi = *(const float4*)(Xin + (size_t)t * D + col), g = *(const float4*)(g2 + (size_t)b * 6144 + col);
    float4 o; o.x = xi.x + g.x * a0; o.y = xi.y + g.y * a1; o.z = xi.z + g.z * a2; o.w = xi.w + g.w * a3;
    *(float4*)(Xout + (size_t)t * D + col) = o;
    __syncthreads();
}

template <class Epi>
__device__ __forceinline__ void gemm_phase(const bf16_t* A, int lda, const bf16_t* Bt, int ldb, int K, int ntm, int ntn, const Epi& epi, unsigned char* lds) {
    const int nt = ntm * ntn;
    for (int w = vblock(); w < nt; w += gridDim.x) gemm_tile(A, lda, Bt, ldb, K, (w / ntn) * 128, (w % ntn) * 128, epi, lds);
}

constexpr int LDS_BYTES = GEMM_LDS + 64;
__global__ void __launch_bounds__(256, 2) mega_fwd(Params p) {
    __shared__ __attribute__((aligned(16))) unsigned char lds[LDS_BYTES];
    volatile LAS unsigned* bst = (volatile LAS unsigned*)(lds + GEMM_LDS);
    if (threadIdx.x == 0) { bst[0] = 0u; bst[1] = 0u; }
    __syncthreads();
    unsigned char* ws = p.ws;
    const XcdBarrier bar = xcd_barrier_post((unsigned*)(ws + WS_CTL), bst);
#define GRID_SYNC() xcd_barrier(bar)
    const float* x = p.in[0]; const float* c = p.in[1]; const float* norm1_g = p.in[2]; const float* norm2_g = p.in[3];
    const float* w_mod = p.in[4]; const float* b_mod = p.in[5]; const float* conv_w_in = p.in[6]; const float* conv_w = p.in[7]; const float* conv_w_out = p.in[8];
    const float* pool_w_in = p.in[9]; const float* pool_w_grp = p.in[10]; const float* pool_scale = p.in[11]; const float* pool_w_out = p.in[12];
    const float* peer_w_q = p.in[13]; const float* peer_k1 = p.in[14]; const float* peer_k2 = p.in[15]; const float* peer_u = p.in[16]; const float* peer_v = p.in[17]; const float* final_g = p.in[18];
    bf16_t* U16 = (bf16_t*)(ws + WS_U16); bf16_t* V16 = (bf16_t*)(ws + WS_V16);
    bf16_t* Wci = (bf16_t*)(ws + WS_WCI); bf16_t* Wco = (bf16_t*)(ws + WS_WCO); bf16_t* Wpi = (bf16_t*)(ws + WS_WPI); bf16_t* Wpg = (bf16_t*)(ws + WS_WPG); bf16_t* Wpo = (bf16_t*)(ws + WS_WPO);
    bf16_t* Wq = (bf16_t*)(ws + WS_WQ); bf16_t* K1 = (bf16_t*)(ws + WS_K1); bf16_t* K2 = (bf16_t*)(ws + WS_K2);
    float* mod = (float*)(ws + WS_MOD);
    bf16_t* Hh = (bf16_t*)(ws + WS_HH); bf16_t* Bg = (bf16_t*)(ws + WS_BG); bf16_t* Vv = (bf16_t*)(ws + WS_VV); bf16_t* Aa = (bf16_t*)(ws + WS_AA);
    float* S1 = (float*)(ws + WS_HH); float* S2 = S1 + (size_t)T * 8 * 128;
    float* XA = (float*)(ws + WS_XA); bf16_t* H2 = (bf16_t*)(ws + WS_H2); bf16_t* Qq = (bf16_t*)(ws + WS_QQ);
    int* IDX = (int*)(ws + WS_IDX); float* GATE = (float*)(ws + WS_GATE);
    float* XB = p.out;
    const int G = gridDim.x;

    {
        constexpr int N_UV = 2 * NE * D / 16384;
        constexpr int N_K = 2 * 128 * 128 / 16384;
        constexpr int I_U = 0, I_V = I_U + N_UV, I_K1 = I_V + N_UV, I_K2 = I_K1 + N_K, I_CI = I_K2 + N_K, I_CO = I_CI + 48 * 16, I_PI = I_CO + 256, I_PG = I_PI + 256, I_PO = I_PG + 64,
                      I_WQ = I_PO + 256, I_MOD = I_WQ + 2 * 32 * 16, I_END = I_MOD + 192;
        for (int w = blockIdx.x; w < I_END; w += G) {
            if (w < I_V) cvt_chunk(peer_u, U16, w - I_U);
            else if (w < I_K1) cvt_chunk(peer_v, V16, w - I_V);
            else if (w < I_K2) cvt_chunk(peer_k1, K1, w - I_K1);
            else if (w < I_CI) cvt_chunk(peer_k2, K2, w - I_K2);
            else if (w < I_CO) { const int i = w - I_CI; transpose_tile<1>(conv_w_in, Wci, D, 3072, i % 48, i / 48, (float*)lds); }
            else if (w < I_PI) { const int i = w - I_CO; transpose_tile<0>(conv_w_out, Wco, D, D, i % 16, i / 16, (float*)lds); }
            else if (w < I_PG) { const int i = w - I_PI; transpose_tile<0>(pool_w_in, Wpi, D, D, i % 16, i / 16, (float*)lds); }
            else if (w < I_PO) { const int i = w - I_PG, g = i >> 4, j = i & 15; transpose_tile<0>(pool_w_grp + (size_t)g * 65536, Wpg + (size_t)g * 65536, 256, 256, j % 4, j / 4, (float*)lds); }
            else if (w < I_WQ) { const int i = w - I_PO; transpose_tile<0>(pool_w_out, Wpo, D, D, i % 16, i / 16, (float*)lds); }
            else if (w < I_MOD) { const int i = w - I_WQ, l = i >> 9, j = i & 511; transpose_tile<0>(peer_w_q + (size_t)l * D * 2048, Wq + (size_t)l * 2048 * D, D, 2048, j % 32, j / 32, (float*)lds); }
            else mod_item(c, w_mod, b_mod, mod, w - I_MOD, (float*)lds);
        }
    }
    GRID_SYNC();

    const float* xin = x;
    for (int l = 0; l < 2; ++l) {
        const float* ml = mod + (size_t)l * 8 * 6144;
        float* x1 = XA; float* x2 = XB;
        { const int tid = otid(); for (int r = blockIdx.x * 4 + (tid >> 6); r < T; r += G * 4) rmsnorm_row<0>(xin, norm1_g + l * D, ml + 0, ml + 1024, Hh, nullptr, r, tid & 63); }
        GRID_SYNC();
        if (l == 0) {
            gemm_phase(Hh, D, Wci, D, D, T / 128, 3072 / 128, EpiConvIn{Bg, Vv}, lds);
            GRID_SYNC();
            for (size_t i = (size_t)blockIdx.x * 256 + otid(); i < (size_t)T * D / 4; i += (size_t)G * 256) conv_elem(Bg, Vv, conv_w, Aa, i);
            GRID_SYNC();
            gemm_phase(Aa, D, Wco, D, D, T / 128, D / 128, EpiResid{xin, x1, ml + 2048}, lds);
        } else {
            gemm_phase(Hh, D, Wpi, D, D, T / 128, D / 128, EpiBf16{Bg, D, 0}, lds);
            GRID_SYNC();
            for (size_t i = (size_t)blockIdx.x * 256 + otid(); i < (size_t)T * D / 4; i += (size_t)G * 256) pool_elem(Bg, Vv, i);
            GRID_SYNC();
            {
                const EpiScaleBf16 epi{Aa, pool_scale, D, 0};
                for (int w = vblock(); w < 128 * 8; w += G) { const int tm = w >> 3, tn = w & 7, g = tn >> 1; gemm_tile(Vv + g * 256, D, Wpg, 256, 256, tm * 128, tn * 128, epi, lds); }
            }
            GRID_SYNC();
            gemm_phase(Aa, D, Wpo, D, D, T / 128, D / 128, EpiResid{xin, x1, ml + 2048}, lds);
        }
        GRID_SYNC();
        { const int tid = otid(); for (int r = blockIdx.x * 4 + (tid >> 6); r < T; r += G * 4) rmsnorm_row<0>(x1, norm2_g + l * D, ml + 3072, ml + 4096, H2, nullptr, r, tid & 63); }
        GRID_SYNC();
        gemm_phase(H2, D, Wq + (size_t)l * 2048 * D, D, D, T / 128, 2048 / 128, EpiBf16{Qq, 2048, 0}, lds);
        GRID_SYNC();
        {
            const EpiF32 e1{S1, 128, 0}, e2{S2, 128, 0};
            for (int w = vblock(); w < 2 * (T * 8 / 128); w += G) { const int half = w & 1, tm = w >> 1;
                if (half == 0) gemm_tile(Qq, 256, K1 + (size_t)l * 16384, 128, 128, tm * 128, 0, e1, lds);
                else gemm_tile(Qq + 128, 256, K2 + (size_t)l * 16384, 128, 128, tm * 128, 0, e2, lds); }
        }
        GRID_SYNC();
        for (size_t pi = (size_t)blockIdx.x * 256 + otid(); pi < (size_t)T * 8; pi += (size_t)G * 256) topk_pair(S1, S2, IDX, GATE, pi);
        GRID_SYNC();
        for (int t = blockIdx.x; t < T; t += G) peer_token(H2, IDX, GATE, U16 + (size_t)l * NE * D, V16 + (size_t)l * NE * D, x1, ml + 5120, x2, t, (float*)lds, (int*)(lds + 1024));
        GRID_SYNC();
        xin = x2;
    }
    { const int tid = otid(); for (int r = blockIdx.x * 4 + (tid >> 6); r < T; r += G * 4) rmsnorm_row<1>(XB, final_g, nullptr, nullptr, nullptr, XB, r, tid & 63); }
}

extern "C" void kernel_launch(void* const* d_in, const int* in_sizes, int n_in, void* d_out, int out_size, void* d_ws, size_t ws_size, hipStream_t stream) {
    static int grid = 0;
    if (grid == 0) {
        if (n_in != 19 || ws_size < WS_END) { fprintf(stderr, "kernel_launch: expected 19 inputs and >= %zu bytes of workspace (got %d, %zu)\n", (size_t)WS_END, n_in, ws_size); grid = -1; return; }
        int dev = 0, cus = 0, per_cu = 0;
        (void)hipGetDevice(&dev);
        (void)hipDeviceGetAttribute(&cus, hipDeviceAttributeMultiprocessorCount, dev);
        (void)hipOccupancyMaxActiveBlocksPerMultiprocessor(&per_cu, (const void*)mega_fwd, 256, 0);
        if (per_cu < 1) { fprintf(stderr, "kernel_launch: occupancy query says %d blocks per CU\n", per_cu); grid = -1; return; }
        if (per_cu > 2) per_cu = 2;
        grid = cus * per_cu;
        fprintf(stderr, "kernel_launch: %d CUs x %d blocks\n", cus, per_cu);
    }
    if (grid < 0) return;
    (void)hipMemsetAsync((unsigned char*)d_ws + WS_CTL, 0, 16384, stream);
    Params p{};
    for (int i = 0; i < 19; ++i) p.in[i] = (const float*)d_in[i];
    p.out = (float*)d_out; p.ws = (unsigned char*)d_ws;
    void* args[] = {&p};
    hipError_t e = hipLaunchCooperativeKernel((const void*)mega_fwd, dim3(grid), dim3(256), args, 0, stream);
    if (e != hipSuccess) fprintf(stderr, "kernel_launch: cooperative launch failed: %s (grid %d)\n", hipGetErrorString(e), grid);
}
```

```cpp
#include <hip/hip_runtime.h>
#include <cstdio>
#include <cstdint>
#include <utility>

typedef unsigned short bf16_t;
typedef short bf16x8 __attribute__((ext_vector_type(8)));
typedef float f32x4 __attribute__((ext_vector_type(4)));
typedef unsigned u32x2 __attribute__((ext_vector_type(2)));
constexpr int NT = 512;

constexpr int D = 1024, NB = 8, SEQ = 2048, T = NB * SEQ;
constexpr int NE = 16384, NH = 8, TOPK = 16, NSEL = NH * TOPK;
constexpr float EPS = 1e-6f;

__device__ __forceinline__ unsigned f2bf(float f) { unsigned u = __builtin_bit_cast(unsigned, f); return (u + 0x7fffu + ((u >> 16) & 1u)) >> 16; }
__device__ __forceinline__ unsigned pk2(float lo, float hi) { return f2bf(lo) | (f2bf(hi) << 16); }
__device__ __forceinline__ float bf_lo(unsigned u) { return __builtin_bit_cast(float, u << 16); }
__device__ __forceinline__ float bf_hi(unsigned u) { return __builtin_bit_cast(float, u & 0xffff0000u); }
__device__ __forceinline__ int otid() { int t = threadIdx.x; asm volatile("" : "+v"(t)); return t; }
__device__ __forceinline__ float shx(float v, int m, int lane) { return __builtin_bit_cast(float, __builtin_amdgcn_ds_bpermute((lane ^ m) << 2, __builtin_bit_cast(int, v))); }
__device__ __forceinline__ float wave_sum(float v, int lane) {
#pragma unroll
    for (int o = 32; o > 0; o >>= 1) v += shx(v, o, lane);
    return v;
}

#define XB_TMO      128
#define XB_XCNT(j)  (256  + 64 * (j))
#define XB_XSUB(j)  (1280 + 64 * (j))
#define XB_XGEN(j)  (2304 + 64 * (j))
#define XB_TOP      3328
#define XB_TOPGEN   3392
#define XCD_BAR_WORDS 3456
#define XB_RANK(j)  (3584 + 64 * (j))
#define CTL_BYTES 32768
#define XB_SPIN_CAP (1u << 18)
#define LAS __attribute__((address_space(3)))
__device__ __forceinline__ unsigned xb_ld(unsigned* p)              { return __hip_atomic_load(p, __ATOMIC_RELAXED, __HIP_MEMORY_SCOPE_AGENT); }
__device__ __forceinline__ unsigned xb_add(unsigned* p, unsigned v) { return __hip_atomic_fetch_add(p, v, __ATOMIC_RELAXED, __HIP_MEMORY_SCOPE_AGENT); }
__device__ __forceinline__ unsigned xb_xcc_id() { return (unsigned)__builtin_amdgcn_s_getreg((3 << 11) | 20) & 0xFu; }
#define XB_SPIN(cond, bar) do { unsigned _sp = 0; while (cond) { __builtin_amdgcn_s_sleep(1); \
    if ((++_sp & 255u) == 0u) { if (xb_ld(&(bar)[XB_TMO])) break; if (_sp > XB_SPIN_CAP) { atomicAdd(&(bar)[XB_TMO], 1u); break; } } } } while (0)
struct XcdBarrier { unsigned* bar; unsigned x; volatile LAS unsigned* st; };
__device__ __forceinline__ XcdBarrier xcd_barrier_post(unsigned* bar, volatile LAS unsigned* st) {
    XcdBarrier b; b.bar = bar; b.x = xb_xcc_id(); b.st = st;
    if (threadIdx.x == 0) (void)xb_add(&bar[XB_XCNT(b.x)], 1u);
    return b;
}
__device__ __forceinline__ void xcd_barrier_complete(unsigned* bar, unsigned x, unsigned& nloc, unsigned& nx) {
    const unsigned G = gridDim.x * gridDim.y * gridDim.z;
    unsigned sum, cnt, mine, sp = 0u;
    for (;;) {
        sum = 0u; cnt = 0u; mine = 0u;
#pragma unroll
        for (unsigned j = 0; j < 16; ++j) { const unsigned c = xb_ld(&bar[XB_XCNT(j)]); sum += c; cnt += (c > 0u) ? 1u : 0u; mine = (j == x) ? c : mine; }
        if (sum == G) break;
        __builtin_amdgcn_s_sleep(1);
        if ((++sp & 255u) == 0u) { if (xb_ld(&bar[XB_TMO])) break; if (sp > XB_SPIN_CAP) { atomicAdd(&bar[XB_TMO], 1u); break; } }
    }
    nloc = mine > 0u ? mine : 1u; nx = cnt > 0u ? cnt : 1u;
}
__device__ __forceinline__ void xcd_barrier(const XcdBarrier& b) {
    asm volatile("s_waitcnt vmcnt(0)" ::: "memory");
    __syncthreads();
    if (threadIdx.x == 0) {
        unsigned* bar = b.bar;
        __builtin_amdgcn_s_waitcnt(0);
        unsigned nloc = b.st[0], nx = b.st[1];
        if (nloc == 0u) { xcd_barrier_complete(bar, b.x, nloc, nx); b.st[0] = nloc; b.st[1] = nx; }
        const unsigned old = xb_add(&bar[XB_XSUB(b.x)], 1u);
        const unsigned gen = old / nloc;
        if (old + 1u == (gen + 1u) * nloc) {
            __builtin_amdgcn_fence(__ATOMIC_RELEASE, "agent");
            asm volatile("s_waitcnt vmcnt(0)" ::: "memory");
            const unsigned og = xb_add(&bar[XB_TOP], 1u);
            const unsigned tg = og / nx;
            if (og + 1u == (tg + 1u) * nx) xb_add(&bar[XB_TOPGEN], 1u);
            else XB_SPIN(xb_ld(&bar[XB_TOPGEN]) == tg, bar);
            __builtin_amdgcn_fence(__ATOMIC_ACQUIRE, "agent");
            xb_add(&bar[XB_XGEN(b.x)], 1u);
            asm volatile("s_waitcnt vmcnt(0)" ::: "memory");
        } else {
            XB_SPIN(xb_ld(&bar[XB_XGEN(b.x)]) == gen, bar);
            __builtin_amdgcn_fence(__ATOMIC_ACQUIRE, "agent");
            asm volatile("s_waitcnt vmcnt(0)" ::: "memory");
        }
    }
    __syncthreads();
}

namespace pg8 {
#define PG8_LAS __attribute__((address_space(3)))
constexpr int BM = 256, BK = 64, HALF = 128, HTB = HALF * BK * 2  , STAGE_BYTES = 8 * HTB, NXCD = 8, WGM = 8;
__host__ __device__ __forceinline__ int lds_byte(int r, int c) { const int st = (r >> 4) * 2 + (c >> 5), rr = r & 15, cc = c & 31, ob = rr * 64 + cc * 2; return st * 1024 + (ob ^ (((ob >> 9) & 1) << 5)); }
__host__ __device__ __forceinline__ void stage_rc(int b, int& R, int& C) { const int st = b / 1024, sb = b % 1024, swz = sb ^ (((sb >> 9) & 1) << 5); R = (st >> 1) * 16 + swz / 64; C = (st & 1) * 32 + (swz % 64) / 2; }
__host__ __device__ __forceinline__ int perm32(int rho) { const int n = rho >> 4, i = rho & 15; return 8 * (i >> 2) + 4 * n + (i & 3); }

struct Unit { int pm, pn; };
struct Gemm { const bf16_t* A; const bf16_t* Bt; int lda, ldb, K, a_colstep; };
struct StaticOrder {
    int nM, nN, nwg, G, c;
    __host__ __device__ void init(int M, int N, int G_, int c_) { nM = M / BM; nN = N / BM; nwg = nM * nN; G = G_; c = c_; }
    __host__ __device__ bool next(int i, Unit& u) const {
        const long L = (long)i * G + c; if (L >= nwg) return false;
        int wgid = (int)L; { const int q = nwg / NXCD, r = nwg % NXCD, xcd = wgid % NXCD, off = wgid / NXCD; wgid = (xcd < r ? xcd * (q + 1) : r * (q + 1) + (xcd - r) * q) + off; }
        const int nig = WGM * nN, gid = wgid / nig, fm = gid * WGM, gsz = (nM - fm) < WGM ? (nM - fm) : WGM;
        u.pm = fm + ((wgid % nig) % gsz); u.pn = (wgid % nig) / gsz; return true;
    }
    __device__ __forceinline__ void a_ready(const Unit&) const {}
    __device__ __forceinline__ void done(const Unit&) const {}
};
template <class Epi, class Sched>
__device__ __forceinline__ void gemm_phase(PG8_LAS unsigned char* lds, const Gemm g, const Sched& S, const Epi& E) {
    const int tid = otid(), wid = __builtin_amdgcn_readfirstlane(tid >> 6), lane = tid & 63, wr = wid >> 2, wc = wid & 3, fr = lane & 15, fq = lane >> 4;
    const int K = g.K, nt = K / BK;
    unsigned voffA[2], voffB[2];
#pragma unroll
    for (int i = 0; i < 2; ++i) { int R, C; stage_rc(tid * 16 + i * 8192, R, C); const int Rb = Epi::PERM ? ((R & ~31) + perm32(R & 31)) : R;
        voffA[i] = (unsigned)(R * g.lda + C) * 2u; voffB[i] = (unsigned)(Rb * g.ldb + C) * 2u; }
    const size_t kstep = (size_t)(BK * 2);
    const size_t hstepA = (size_t)HALF * g.lda * 2, hstepB = (size_t)HALF * g.ldb * 2;
    const size_t tstepA = 2 * hstepA, tstepB = 2 * hstepB;
    const size_t acs = (size_t)g.a_colstep;
    const unsigned ldsw = (unsigned)wid * 1024u;
    const int aoff = lds_byte(wr * 64 + fr, fq * 8), boff = lds_byte(wc * 32 + fr, fq * 8);
#define PG8_SA(b, h) (((b) * 2 + (h)) * HTB)
#define PG8_SB(b, h) ((4 + (b) * 2 + (h)) * HTB)
#define PG8_STAGE(bufoff, gbase, voff) do { _Pragma("unroll") for (int _i = 0; _i < 2; ++_i) \
        __builtin_amdgcn_global_load_lds((const unsigned*)((const char*)(gbase) + (voff)[_i]), (PG8_LAS unsigned*)(lds + (bufoff) + ldsw + _i * 8192), 16, 0, 0); } while (0)
#define PG8_LDA(dst, b, h) do { _Pragma("unroll") for (int m = 0; m < 4; ++m) _Pragma("unroll") for (int k = 0; k < 2; ++k) dst[m][k] = *(const PG8_LAS bf16x8*)(lds + PG8_SA(b, h) + aoff + m * 2048 + k * 1024); } while (0)
#define PG8_LDB(dst, b, h) do { _Pragma("unroll") for (int n = 0; n < 2; ++n) _Pragma("unroll") for (int k = 0; k < 2; ++k) dst[n][k] = *(const PG8_LAS bf16x8*)(lds + PG8_SB(b, h) + boff + n * 2048 + k * 1024); } while (0)
#define PG8_MMA(ai, bj, At, Bt) do { __builtin_amdgcn_s_setprio(1); _Pragma("unroll") for (int m = 0; m < 4; ++m) _Pragma("unroll") for (int n = 0; n < 2; ++n) _Pragma("unroll") for (int k = 0; k < 2; ++k) \
        acc[ai][bj][m][n] = __builtin_amdgcn_mfma_f32_16x16x32_bf16(Bt[n][k], At[m][k], acc[ai][bj][m][n], 0, 0, 0); __builtin_amdgcn_s_setprio(0); } while (0)
#define PG8_WAIT_V(n) asm volatile("s_waitcnt vmcnt(" #n ")" ::: "memory")
#define PG8_WAIT_L(n) asm volatile("s_waitcnt lgkmcnt(" #n ")" ::: "memory")
#define PG8_BAR __builtin_amdgcn_s_barrier()
#define PG8_SCHED __builtin_amdgcn_sched_barrier(0)
    Unit cur, nxt; int ui = 0;
    if (!S.next(0, cur)) return;
    f32x4 acc[2][2][4][2];
#pragma unroll
    for (int a = 0; a < 2; ++a)
#pragma unroll
        for (int b = 0; b < 2; ++b)
#pragma unroll
            for (int m = 0; m < 4; ++m)
#pragma unroll
                for (int n = 0; n < 2; ++n) acc[a][b][m][n] = (f32x4){0.f, 0.f, 0.f, 0.f};
    bf16x8 At[4][2], B0[2][2], B1[2][2];
    const char* cA = (const char*)g.A + (size_t)cur.pm * tstepA + (size_t)cur.pn * acs; const char* cB = (const char*)g.Bt + (size_t)cur.pn * tstepB;
    S.a_ready(cur);
    PG8_STAGE(PG8_SB(0, 0), cB, voffB); PG8_STAGE(PG8_SA(0, 0), cA, voffA); PG8_STAGE(PG8_SB(0, 1), cB + hstepB, voffB); PG8_STAGE(PG8_SA(0, 1), cA + hstepA, voffA);
    if (wr == 1) PG8_BAR;
    PG8_WAIT_V(4); PG8_BAR;
    PG8_STAGE(PG8_SB(1, 0), cB + kstep, voffB); PG8_STAGE(PG8_SA(1, 0), cA + kstep, voffA); PG8_STAGE(PG8_SB(1, 1), cB + hstepB + kstep, voffB);
    PG8_WAIT_V(6); PG8_BAR;
    for (;;) {
        const bool has_next = S.next(ui + 1, nxt);
        const char* nA = has_next ? (const char*)g.A + (size_t)nxt.pm * tstepA + (size_t)nxt.pn * acs : cA; const char* nB = has_next ? (const char*)g.Bt + (size_t)nxt.pn * tstepB : cB;
        for (int t = 0; t < nt; t += 2) {
            const bool last = (t == nt - 2);
            const char* a1 = cA + (size_t)(t + 1) * kstep;
            const char* a2 = last ? nA : cA + (size_t)(t + 2) * kstep; const char* b2 = last ? nB : cB + (size_t)(t + 2) * kstep;
            const char* a3 = a2 + kstep; const char* b3 = b2 + kstep;
            if (last && has_next) S.a_ready(nxt);
            PG8_LDB(B0, 0, 0); PG8_SCHED; PG8_LDA(At, 0, 0); PG8_STAGE(PG8_SA(1, 1), a1 + hstepA, voffA);
            PG8_WAIT_L(8); PG8_BAR; PG8_WAIT_L(0); PG8_MMA(0, 0, At, B0); PG8_BAR; PG8_SCHED;
            PG8_LDB(B1, 0, 1); PG8_STAGE(PG8_SB(0, 0), b2, voffB);
            PG8_BAR; PG8_WAIT_L(0); PG8_MMA(0, 1, At, B1); PG8_BAR;
            PG8_LDA(At, 0, 1); PG8_STAGE(PG8_SA(0, 0), a2, voffA);
            PG8_BAR; PG8_WAIT_L(0); PG8_MMA(1, 0, At, B0); PG8_BAR; PG8_SCHED;
            PG8_STAGE(PG8_SB(0, 1), b2 + hstepB, voffB);
            PG8_WAIT_V(6); PG8_BAR; PG8_MMA(1, 1, At, B1); PG8_BAR;
            PG8_LDB(B0, 1, 0); PG8_SCHED; PG8_LDA(At, 1, 0); PG8_STAGE(PG8_SA(0, 1), a2 + hstepA, voffA);
            PG8_WAIT_L(8); PG8_BAR; PG8_WAIT_L(0); PG8_MMA(0, 0, At, B0); PG8_BAR; PG8_SCHED;
            PG8_LDB(B1, 1, 1); PG8_STAGE(PG8_SB(1, 0), b3, voffB);
            PG8_BAR; PG8_WAIT_L(0); PG8_MMA(0, 1, At, B1); PG8_BAR;
            PG8_LDA(At, 1, 1); PG8_STAGE(PG8_SA(1, 0), a3, voffA);
            PG8_BAR; PG8_WAIT_L(0); PG8_MMA(1, 0, At, B0); PG8_BAR; PG8_SCHED;
            PG8_STAGE(PG8_SB(1, 1), b3 + hstepB, voffB);
            PG8_WAIT_V(6); PG8_BAR; PG8_MMA(1, 1, At, B1); PG8_BAR;
        }
            if constexpr (!Epi::AFTER_DRAIN) { int te = tid; asm volatile("" : "+v"(te));
            const int we = __builtin_amdgcn_readfirstlane(te >> 6), le = te & 63; E(acc, cur, we >> 2, we & 3, le & 15, le >> 4); S.done(cur); }
            if (!has_next) break;
#pragma unroll
        for (int a = 0; a < 2; ++a)
#pragma unroll
            for (int b = 0; b < 2; ++b)
#pragma unroll
                for (int m = 0; m < 4; ++m)
#pragma unroll
                    for (int n = 0; n < 2; ++n) acc[a][b][m][n] = (f32x4){0.f, 0.f, 0.f, 0.f};
        cur = nxt; cA = nA; cB = nB; ++ui;
    }
    PG8_WAIT_V(0);
    if (wr == 0) PG8_BAR;
    PG8_BAR;
    if constexpr (Epi::AFTER_DRAIN) { E.fused(acc, cur, wr, wc, fr, fq, lds, wid, lane); S.done(cur); }
#undef PG8_SA
#undef PG8_SB
#undef PG8_STAGE
#undef PG8_LDA
#undef PG8_LDB
#undef PG8_MMA
#undef PG8_WAIT_V
#undef PG8_WAIT_L
#undef PG8_BAR
#undef PG8_SCHED
}
}

using pg8::Unit;
struct EpiBf16 {
    static constexpr bool PERM = false, AFTER_DRAIN = false;
    bf16_t* O; int ldc; int pad;
    __device__ __forceinline__ void operator()(const f32x4 (&acc)[2][2][4][2], const Unit& u, int wr, int wc, int fr, int fq) const {
        const int row0 = u.pm * 256 + wr * 64 + fr, col0 = u.pn * 256 + wc * 32 + 4 * fq;
#pragma unroll
        for (int ai = 0; ai < 2; ++ai)
#pragma unroll
            for (int m = 0; m < 4; ++m) { bf16_t* rowp = O + (size_t)(row0 + ai * 128 + m * 16) * ldc + col0;
#pragma unroll
                for (int bj = 0; bj < 2; ++bj)
#pragma unroll
                    for (int n = 0; n < 2; ++n) { const f32x4 v = acc[ai][bj][m][n]; u32x2 o; o.x = pk2(v[0], v[1]); o.y = pk2(v[2], v[3]); *(u32x2*)(rowp + bj * 128 + n * 16) = o; } }
    }
};
struct EpiF32 {
    static constexpr bool PERM = false, AFTER_DRAIN = false;
    float* O; int ldc; int pad;
    __device__ __forceinline__ void operator()(const f32x4 (&acc)[2][2][4][2], const Unit& u, int wr, int wc, int fr, int fq) const {
        const int row0 = u.pm * 256 + wr * 64 + fr, col0 = u.pn * 256 + wc * 32 + 4 * fq;
#pragma unroll
        for (int ai = 0; ai < 2; ++ai)
#pragma unroll
            for (int m = 0; m < 4; ++m) { float* rowp = O + (size_t)(row0 + ai * 128 + m * 16) * ldc + col0;
#pragma unroll
                for (int bj = 0; bj < 2; ++bj)
#pragma unroll
                    for (int n = 0; n < 2; ++n) *(f32x4*)(rowp + bj * 128 + n * 16) = acc[ai][bj][m][n]; }
    }
};
struct EpiScaleBf16 {
    static constexpr bool PERM = false, AFTER_DRAIN = false;
    bf16_t* O; const float* scale; int ldc; int pad;
    __device__ __forceinline__ void operator()(const f32x4 (&acc)[2][2][4][2], const Unit& u, int wr, int wc, int fr, int fq) const {
        const int row0 = u.pm * 256 + wr * 64 + fr, col0 = u.pn * 256 + wc * 32 + 4 * fq;
        f32x4 sv[2][2];
#pragma unroll
        for (int bj = 0; bj < 2; ++bj)
#pragma unroll
            for (int n = 0; n < 2; ++n) sv[bj][n] = *(const f32x4*)(scale + col0 + bj * 128 + n * 16);
#pragma unroll
        for (int ai = 0; ai < 2; ++ai)
#pragma unroll
            for (int m = 0; m < 4; ++m) { bf16_t* rowp = O + (size_t)(row0 + ai * 128 + m * 16) * ldc + col0;
#pragma unroll
                for (int bj = 0; bj < 2; ++bj)
#pragma unroll
                    for (int n = 0; n < 2; ++n) { const f32x4 v = acc[ai][bj][m][n] * sv[bj][n]; u32x2 o; o.x = pk2(v[0], v[1]); o.y = pk2(v[2], v[3]); *(u32x2*)(rowp + bj * 128 + n * 16) = o; } }
    }
};
struct EpiResid {
    static constexpr bool PERM = false, AFTER_DRAIN = false;
    const float* Xin; float* Xout; const float* gate;
    __device__ __forceinline__ void operator()(const f32x4 (&acc)[2][2][4][2], const Unit& u, int wr, int wc, int fr, int fq) const {
        const int row0 = u.pm * 256 + wr * 64 + fr, col0 = u.pn * 256 + wc * 32 + 4 * fq, b = (u.pm * 256) / SEQ;
        f32x4 gv[2][2];
#pragma unroll
        for (int bj = 0; bj < 2; ++bj)
#pragma unroll
            for (int n = 0; n < 2; ++n) gv[bj][n] = *(const f32x4*)(gate + (size_t)b * 6144 + col0 + bj * 128 + n * 16);
#pragma unroll
        for (int ai = 0; ai < 2; ++ai)
#pragma unroll
            for (int m = 0; m < 4; ++m) { const size_t ro = (size_t)(row0 + ai * 128 + m * 16) * D + col0;
#pragma unroll
                for (int bj = 0; bj < 2; ++bj)
#pragma unroll
                    for (int n = 0; n < 2; ++n) { const f32x4 xi = *(const f32x4*)(Xin + ro + bj * 128 + n * 16); *(f32x4*)(Xout + ro + bj * 128 + n * 16) = xi + gv[bj][n] * acc[ai][bj][m][n]; } }
    }
};
struct EpiConvIn {
    static constexpr bool PERM = false, AFTER_DRAIN = false;
    bf16_t* Bg; bf16_t* Vv;
    __device__ __forceinline__ void operator()(const f32x4 (&acc)[2][2][4][2], const Unit& u, int wr, int wc, int fr, int fq) const {
        const int row0 = u.pm * 256 + wr * 64 + fr, colt = u.pn * 256;
        if (colt < 1024) {
            const int col0 = colt + wc * 32 + 4 * fq;
#pragma unroll
            for (int ai = 0; ai < 2; ++ai)
#pragma unroll
                for (int m = 0; m < 4; ++m) { bf16_t* rowp = Bg + (size_t)(row0 + ai * 128 + m * 16) * D + col0;
#pragma unroll
                    for (int bj = 0; bj < 2; ++bj)
#pragma unroll
                        for (int n = 0; n < 2; ++n) { const f32x4 v = acc[ai][bj][m][n]; u32x2 o; o.x = pk2(v[0], v[1]); o.y = pk2(v[2], v[3]); *(u32x2*)(rowp + bj * 128 + n * 16) = o; } }
        } else {
            const int g0 = (colt - 1024) / 32 + wc;
#pragma unroll
            for (int ai = 0; ai < 2; ++ai)
#pragma unroll
                for (int m = 0; m < 4; ++m) { bf16_t* rowp = Vv + (size_t)(row0 + ai * 128 + m * 16) * D + 4 * fq;
#pragma unroll
                    for (int bj = 0; bj < 2; ++bj) { const f32x4 v = acc[ai][bj][m][0] * acc[ai][bj][m][1]; u32x2 o; o.x = pk2(v[0], v[1]); o.y = pk2(v[2], v[3]);
                        *(u32x2*)(rowp + (g0 + 4 * bj) * 16) = o; } }
        }
    }
};

constexpr size_t al256(size_t x) { return (x + 255) & ~(size_t)255; }
constexpr size_t WS_CTL  = 0;
constexpr size_t WS_U16  = al256(WS_CTL + CTL_BYTES);
constexpr size_t WS_V16  = WS_U16 + (size_t)2 * NE * D * 2;
constexpr size_t WS_WCI  = WS_V16 + (size_t)2 * NE * D * 2;
constexpr size_t WS_WCO  = WS_WCI + (size_t)3072 * D * 2;
constexpr size_t WS_WPI  = WS_WCO + (size_t)D * D * 2;
constexpr size_t WS_WPG  = WS_WPI + (size_t)D * D * 2;
constexpr size_t WS_WPO  = WS_WPG + (size_t)4 * 256 * 256 * 2;
constexpr size_t WS_WQ   = WS_WPO + (size_t)D * D * 2;
constexpr size_t WS_KBD  = WS_WQ + (size_t)2 * 2048 * D * 2;
constexpr size_t WS_MOD  = WS_KBD + (size_t)2 * 256 * 256 * 2;
constexpr size_t WS_HH   = al256(WS_MOD + (size_t)2 * 8 * 6144 * 4);
constexpr size_t WS_BG   = WS_HH + (size_t)T * D * 2;
constexpr size_t WS_VV   = WS_BG + (size_t)T * D * 2;
constexpr size_t WS_AA   = WS_VV + (size_t)T * D * 2;
constexpr size_t WS_XA   = WS_AA + (size_t)T * D * 2;
constexpr size_t WS_H2   = WS_XA + (size_t)T * D * 4;
constexpr size_t WS_QQ   = WS_H2 + (size_t)T * D * 2;
constexpr size_t WS_IDX  = WS_QQ + (size_t)T * 2048 * 2;
constexpr size_t WS_GATE = WS_IDX + (size_t)T * NSEL * 4;
constexpr size_t WS_END  = WS_GATE + (size_t)T * NSEL * 4;

struct Params { const float* in[19]; float* out; unsigned char* ws; };

template <int MODE>
__device__ __forceinline__ void transpose_tile(const float* __restrict__ W, bf16_t* __restrict__ Wt, int K, int N, int tn, int tk, float* tile  ) {
    const int tid = otid(), n0 = tn * 64, k0 = tk * 64, tx = tid & 63, ty = tid >> 6;
#pragma unroll
    for (int i = 0; i < 8; ++i) tile[(ty + 8 * i) * 65 + tx] = W[(size_t)(k0 + ty + 8 * i) * N + n0 + tx];
    __syncthreads();
#pragma unroll
    for (int i = 0; i < 8; ++i) {
        int n = n0 + ty + 8 * i, p = n;
        if (MODE == 1 && n >= 1024) { const int j = (n - 1024) & 1023, isu = (n >= 2048); p = 1024 + (j >> 4) * 32 + isu * 16 + (j & 15); }
        Wt[(size_t)p * K + k0 + tx] = (bf16_t)f2bf(tile[tx * 65 + ty + 8 * i]);
    }
    __syncthreads();
}
__device__ __forceinline__ void cvt_sliced(const float* __restrict__ src, bf16_t* __restrict__ dst, size_t item) {
    const int tid = otid();
#pragma unroll
    for (int r = 0; r < 4; ++r) {
        const size_t i = item * 2048 + r * NT + tid;
        const float4 a = ((const float4*)src)[2 * i], b = ((const float4*)src)[2 * i + 1];
        uint4 o; o.x = pk2(a.x, a.y); o.y = pk2(a.z, a.w); o.z = pk2(b.x, b.y); o.w = pk2(b.z, b.w);
        const size_t R = i >> 7, l = R >> 14, e = R & (NE - 1); const int gq = (int)(i & 127), sl = gq >> 3, c8 = gq & 7;
        ((uint4*)dst)[(((l * 16 + sl) * NE + e) << 3) + c8] = o;
    }
}
__device__ __forceinline__ void kbd_item(const float* __restrict__ k1, const float* __restrict__ k2, bf16_t* __restrict__ Kbd, int item) {
    const int tid = otid(), l = item >> 3, r0 = (item & 7) * 32;
#pragma unroll
    for (int i = 0; i < 16; ++i) { const int e = i * NT + tid, n = r0 + (e >> 8), k = e & 255;
        float v = 0.f;
        if (n < 128) { if (k < 128) v = k1[((size_t)l * 128 + n) * 128 + k]; } else { if (k >= 128) v = k2[((size_t)l * 128 + n - 128) * 128 + k - 128]; }
        Kbd[((size_t)l * 256 + n) * 256 + k] = (bf16_t)f2bf(v); }
}
__device__ __forceinline__ void mod_item(const float* __restrict__ cact, const float* __restrict__ w_mod, const float* __restrict__ b_mod, float* __restrict__ mod, int item, float* red  ) {
    const int tid = otid(), l = item / 96, n0 = (item % 96) * 64, col = tid & 63, kg = tid >> 6;
    float acc[8] = {0, 0, 0, 0, 0, 0, 0, 0};
    const float* w = w_mod + (size_t)l * D * 6144 + (size_t)(kg * 128) * 6144 + n0 + col;
#pragma unroll 8
    for (int k = 0; k < 128; ++k) { const float wv = w[(size_t)k * 6144];
#pragma unroll
        for (int b = 0; b < 8; ++b) acc[b] += cact[b * D + kg * 128 + k] * wv; }
#pragma unroll
    for (int b = 0; b < 8; ++b) red[(kg * 8 + b) * 64 + col] = acc[b];
    __syncthreads();
    { const int b = tid >> 6, cc = tid & 63; float s = b_mod[l * 6144 + n0 + cc];
#pragma unroll
      for (int q = 0; q < 8; ++q) s += red[(q * 8 + b) * 64 + cc];
      mod[((size_t)l * 8 + b) * 6144 + n0 + cc] = s; }
    __syncthreads();
}

template <int MODE>
__device__ __forceinline__ void rmsnorm_row(const float* x, const float* __restrict__ g, const float* __restrict__ sh, const float* __restrict__ sc, bf16_t* ob, float* of, int row, int lane) {
    const int b = row / SEQ;
    const float4* xr = (const float4*)(x + (size_t)row * D);
    float4 v[4]; float ss = 0.f;
#pragma unroll
    for (int i = 0; i < 4; ++i) { v[i] = xr[lane + 64 * i]; ss += v[i].x * v[i].x + v[i].y * v[i].y + v[i].z * v[i].z + v[i].w * v[i].w; }
    ss = wave_sum(ss, lane);
    const float r = rsqrtf(ss * (1.0f / D) + EPS);
#pragma unroll
    for (int i = 0; i < 4; ++i) {
        const int c4 = lane + 64 * i; const float4 gg = ((const float4*)g)[c4];
        float4 y; y.x = v[i].x * r * gg.x; y.y = v[i].y * r * gg.y; y.z = v[i].z * r * gg.z; y.w = v[i].w * r * gg.w;
        if (MODE == 0) {
            const float4 s1 = ((const float4*)(sc + (size_t)b * 6144))[c4], s0 = ((const float4*)(sh + (size_t)b * 6144))[c4];
            y.x = y.x * (1.f + s1.x) + s0.x; y.y = y.y * (1.f + s1.y) + s0.y; y.z = y.z * (1.f + s1.z) + s0.z; y.w = y.w * (1.f + s1.w) + s0.w;
            uint2 o; o.x = pk2(y.x, y.y); o.y = pk2(y.z, y.w);
            ((uint2*)(ob + (size_t)row * D))[c4] = o;
        } else ((float4*)(of + (size_t)row * D))[c4] = y;
    }
}
__device__ __forceinline__ int ord_key(float f) { const int b = __builtin_bit_cast(int, f); return b >= 0 ? b : (b ^ 0x7fffffff); }
__device__ __forceinline__ float key_val(int k) { const int b = k >= 0 ? k : (k ^ 0x7fffffff); return __builtin_bit_cast(float, b); }
__device__ __forceinline__ void ce(int& hi, int& lo) { const int a = hi, b = lo; hi = a > b ? a : b; lo = a > b ? b : a; }
__device__ __forceinline__ void sort16_desc(int (&v)[16]) {
#pragma unroll
    for (int ks = 1; ks <= 4; ++ks)
#pragma unroll
        for (int js = ks - 1; js >= 0; --js)
#pragma unroll
            for (int i = 0; i < 16; ++i) { const int k = 1 << ks, j = 1 << js, l = i ^ j; if (l > i) { if ((i & k) == 0) ce(v[i], v[l]); else ce(v[l], v[i]); } }
}
__device__ __forceinline__ void merge16_desc(int (&a)[16], const int (&b)[16]) {
#pragma unroll
    for (int i = 0; i < 16; ++i) a[i] = a[i] > b[15 - i] ? a[i] : b[15 - i];
#pragma unroll
    for (int js = 3; js >= 0; --js)
#pragma unroll
        for (int i = 0; i < 16; ++i) { const int j = 1 << js, l = i ^ j; if (l > i) ce(a[i], a[l]); }
}
__host__ __device__ constexpr int cand_ij(int c) { int n = 0; for (int i = 0; i < 16; ++i) for (int j = 0; j < 16; ++j) if ((i + 1) * (j + 1) <= 16) { if (n == c) return i * 16 + j; ++n; } return -1; }
constexpr int NCAND = 50;
static_assert(cand_ij(NCAND - 1) >= 0 && cand_ij(NCAND) < 0, "candidate count");
template <int C> __device__ __forceinline__ void cand_step(const float (&v1)[16], const float (&v2)[16], int (&cur)[16], int (&run)[16]) {
    constexpr int ij = cand_ij(C), i = ij >> 4, j = ij & 15;
    cur[C & 15] = (ord_key(v1[i] + v2[j]) & ~255) | ij;
    if constexpr ((C & 15) == 15 || C == NCAND - 1) {
        if constexpr (C == NCAND - 1) {
#pragma unroll
            for (int q = (C & 15) + 1; q < 16; ++q) cur[q] = (int)0x80000000;
        }
        sort16_desc(cur);
        if constexpr (C == 15) {
#pragma unroll
            for (int q = 0; q < 16; ++q) run[q] = cur[q];
        } else merge16_desc(run, cur);
    }
}
template <int... C> __device__ __forceinline__ void cand_all(std::integer_sequence<int, C...>, const float (&v1)[16], const float (&v2)[16], int (&cur)[16], int (&run)[16]) { (cand_step<C>(v1, v2, cur, run), ...); }
__device__ __forceinline__ void top16_of_128(const float* __restrict__ s, int (&run)[16]) {
#pragma unroll 1
    for (int g = 0; g < 8; ++g) {
        int cur[16];
#pragma unroll
        for (int q = 0; q < 4; ++q) { const float4 v = ((const float4*)s)[g * 4 + q];
            cur[4 * q + 0] = (ord_key(v.x) & ~127) | (g * 16 + 4 * q + 0); cur[4 * q + 1] = (ord_key(v.y) & ~127) | (g * 16 + 4 * q + 1);
            cur[4 * q + 2] = (ord_key(v.z) & ~127) | (g * 16 + 4 * q + 2); cur[4 * q + 3] = (ord_key(v.w) & ~127) | (g * 16 + 4 * q + 3); }
        sort16_desc(cur);
        if (g == 0) {
#pragma unroll
            for (int i = 0; i < 16; ++i) run[i] = cur[i];
        } else merge16_desc(run, cur);
    }
}
__device__ __forceinline__ int lut16(const int (&p)[4], int i) {
    const int r = i >> 2; const int w = r == 0 ? p[0] : (r == 1 ? p[1] : (r == 2 ? p[2] : p[3]));
    return (w >> ((i & 3) * 8)) & 127;
}
__device__ __forceinline__ void conv_elem(const bf16_t* __restrict__ Bg, const bf16_t* __restrict__ Vv, const float* __restrict__ cw, bf16_t* __restrict__ Aa, size_t i) {
    const int t = (int)(i >> 8), c4 = (int)(i & 255), s = t & (SEQ - 1);
    const uint2 b = ((const uint2*)Bg)[i], v2 = ((const uint2*)Vv)[i];
    uint2 v1 = make_uint2(0, 0), v0 = make_uint2(0, 0);
    if (s >= 1) v1 = ((const uint2*)Vv)[i - 256];
    if (s >= 2) v0 = ((const uint2*)Vv)[i - 512];
    const float4 w0 = ((const float4*)cw)[c4], w1 = ((const float4*)(cw + D))[c4], w2 = ((const float4*)(cw + 2 * D))[c4];
    const float r0 = bf_lo(b.x) * (w0.x * bf_lo(v0.x) + w1.x * bf_lo(v1.x) + w2.x * bf_lo(v2.x));
    const float r1 = bf_hi(b.x) * (w0.y * bf_hi(v0.x) + w1.y * bf_hi(v1.x) + w2.y * bf_hi(v2.x));
    const float r2 = bf_lo(b.y) * (w0.z * bf_lo(v0.y) + w1.z * bf_lo(v1.y) + w2.z * bf_lo(v2.y));
    const float r3 = bf_hi(b.y) * (w0.w * bf_hi(v0.y) + w1.w * bf_hi(v1.y) + w2.w * bf_hi(v2.y));
    uint2 o; o.x = pk2(r0, r1); o.y = pk2(r2, r3);
    ((uint2*)Aa)[i] = o;
}
__device__ __forceinline__ void pool_elem(const bf16_t* __restrict__ Uu, bf16_t* __restrict__ Pp, size_t i) {
    const int t = (int)(i >> 8), c4 = (int)(i & 255), s = t & (SEQ - 1);
    const int w = 2 << (c4 >> 6);
    const int cnt = (s + 1 < w) ? s + 1 : w;
    float a0 = 0.f, a1 = 0.f, a2 = 0.f, a3 = 0.f;
    const uint2 cur = ((const uint2*)Uu)[i];
    for (int k = 0; k < cnt; ++k) { const uint2 v = ((const uint2*)Uu)[i - (size_t)k * 256]; a0 += bf_lo(v.x); a1 += bf_hi(v.x); a2 += bf_lo(v.y); a3 += bf_hi(v.y); }
    const float inv = 1.0f / (float)cnt;
    uint2 o; o.x = pk2(a0 * inv - bf_lo(cur.x), a1 * inv - bf_hi(cur.x)); o.y = pk2(a2 * inv - bf_lo(cur.y), a3 * inv - bf_hi(cur.y));
    ((uint2*)Pp)[i] = o;
}

__device__ __forceinline__ void topk_pair(const float* __restrict__ S, int* __restrict__ IDX, float* __restrict__ GATE, size_t p) {
    int k1[16], k2[16];
    top16_of_128(S + p * 256, k1);
    top16_of_128(S + p * 256 + 128, k2);
    float v1[16], v2[16]; int id1[4] = {0, 0, 0, 0}, id2[4] = {0, 0, 0, 0};
#pragma unroll
    for (int i = 0; i < 16; ++i) { v1[i] = key_val(k1[i] & ~127); v2[i] = key_val(k2[i] & ~127); id1[i >> 2] |= (k1[i] & 127) << ((i & 3) * 8); id2[i >> 2] |= (k2[i] & 127) << ((i & 3) * 8); }
    int run[16];
    { int cur[16]; cand_all(std::make_integer_sequence<int, NCAND>{}, v1, v2, cur, run); }
    float sc[16], e[16], sum = 0.f;
#pragma unroll
    for (int i = 0; i < 16; ++i) sc[i] = key_val(run[i] & ~255);
#pragma unroll
    for (int i = 0; i < 16; ++i) { e[i] = __expf(sc[i] - sc[0]); sum += e[i]; }
    const float inv = 1.0f / sum;
    int* io = IDX + p * 16; float* go = GATE + p * 16;
#pragma unroll
    for (int q = 0; q < 4; ++q) {
        int4 iv; float4 gv;
        { const int f = run[4 * q + 0] & 255; iv.x = lut16(id1, f >> 4) * 128 + lut16(id2, f & 15); gv.x = e[4 * q + 0] * inv; }
        { const int f = run[4 * q + 1] & 255; iv.y = lut16(id1, f >> 4) * 128 + lut16(id2, f & 15); gv.y = e[4 * q + 1] * inv; }
        { const int f = run[4 * q + 2] & 255; iv.z = lut16(id1, f >> 4) * 128 + lut16(id2, f & 15); gv.z = e[4 * q + 2] * inv; }
        { const int f = run[4 * q + 3] & 255; iv.w = lut16(id1, f >> 4) * 128 + lut16(id2, f & 15); gv.w = e[4 * q + 3] * inv; }
        ((int4*)io)[q] = iv; ((float4*)go)[q] = gv;
    }
}

typedef __bf16 bf2_t __attribute__((ext_vector_type(2)));
typedef float f32x2 __attribute__((ext_vector_type(2)));
__device__ __forceinline__ float dot2bf(unsigned a, unsigned b, float c) { return __builtin_amdgcn_fdot2_f32_bf16(__builtin_bit_cast(bf2_t, a), __builtin_bit_cast(bf2_t, b), c, false); }
#define LOAD_IDS16(id, p) { const int4 _a = (p)[0], _b = (p)[1], _c = (p)[2], _d = (p)[3]; id[0] = _a.x; id[1] = _a.y; id[2] = _a.z; id[3] = _a.w; id[4] = _b.x; id[5] = _b.y; id[6] = _b.z; id[7] = _b.w; \
    id[8] = _c.x; id[9] = _c.y; id[10] = _c.z; id[11] = _c.w; id[12] = _d.x; id[13] = _d.y; id[14] = _d.z; id[15] = _d.w; }
__device__ __forceinline__ void peer_u_tokens(const bf16_t* __restrict__ H2, const int* __restrict__ IDX, const unsigned char* __restrict__ tab, float* __restrict__ PARTs, int s, int t0, int t1, int lane) {
    const int g = lane >> 3, j = lane & 7;
    const unsigned char* tb = tab + j * 16;
    const bool b4 = (j & 4) != 0, b2 = (j & 2) != 0, b1 = (j & 1) != 0;
    for (int t = t0; t < t1; ++t) {
        int id[16];
        LOAD_IDS16(id, (const int4*)(IDX + (size_t)t * NSEL + g * 16));
        const uint4 hv = *(const uint4*)(H2 + (size_t)t * D + s * 64 + j * 8);
        uint4 r[16];
#pragma unroll
        for (int i = 0; i < 16; ++i) r[i] = *(const uint4*)(tb + (unsigned)id[i] * 128u);
        float a[16];
#pragma unroll
        for (int i = 0; i < 16; ++i) a[i] = dot2bf(hv.x, r[i].x, dot2bf(hv.y, r[i].y, dot2bf(hv.z, r[i].z, dot2bf(hv.w, r[i].w, 0.f))));
        float b8[8], c4[4], d2[2];
#pragma unroll
        for (int i = 0; i < 8; ++i) { const float keep = b4 ? a[i + 8] : a[i], send = b4 ? a[i] : a[i + 8]; b8[i] = keep + shx(send, 4, lane); }
#pragma unroll
        for (int i = 0; i < 4; ++i) { const float keep = b2 ? b8[i + 4] : b8[i], send = b2 ? b8[i] : b8[i + 4]; c4[i] = keep + shx(send, 2, lane); }
#pragma unroll
        for (int i = 0; i < 2; ++i) { const float keep = b1 ? c4[i + 2] : c4[i], send = b1 ? c4[i] : c4[i + 2]; d2[i] = keep + shx(send, 1, lane); }
        *(float2*)(PARTs + (size_t)t * NSEL + lane * 2) = make_float2(d2[0], d2[1]);
    }
}
__device__ __forceinline__ void peer_v_tokens(const float* __restrict__ W, const int* __restrict__ IDX, const unsigned char* __restrict__ tab, const float* __restrict__ Xin, const float* __restrict__ g2,
                                              float* __restrict__ Xout, int s, int t0, int t1, int lane) {
    const int g = lane >> 3, j = lane & 7;
    const unsigned char* tb = tab + j * 16;
    const bool g4 = (g & 4) != 0, g2b = (g & 2) != 0, g1 = (g & 1) != 0;
    const int col = s * 64 + j * 8 + g;
    for (int t = t0; t < t1; ++t) {
        int id[16]; float w[16];
        LOAD_IDS16(id, (const int4*)(IDX + (size_t)t * NSEL + g * 16));
        { const float4* wp = (const float4*)(W + (size_t)t * NSEL + g * 16); const float4 a = wp[0], b = wp[1], c = wp[2], d = wp[3];
          w[0] = a.x; w[1] = a.y; w[2] = a.z; w[3] = a.w; w[4] = b.x; w[5] = b.y; w[6] = b.z; w[7] = b.w; w[8] = c.x; w[9] = c.y; w[10] = c.z; w[11] = c.w; w[12] = d.x; w[13] = d.y; w[14] = d.z; w[15] = d.w; }
        uint4 r[16];
#pragma unroll
        for (int i = 0; i < 16; ++i) r[i] = *(const uint4*)(tb + (unsigned)id[i] * 128u);
        f32x2 acc[4] = {{0.f, 0.f}, {0.f, 0.f}, {0.f, 0.f}, {0.f, 0.f}};
#pragma unroll
        for (int i = 0; i < 16; ++i) { const f32x2 ww = {w[i], w[i]};
            acc[0] += ww * (f32x2){bf_lo(r[i].x), bf_hi(r[i].x)}; acc[1] += ww * (f32x2){bf_lo(r[i].y), bf_hi(r[i].y)};
            acc[2] += ww * (f32x2){bf_lo(r[i].z), bf_hi(r[i].z)}; acc[3] += ww * (f32x2){bf_lo(r[i].w), bf_hi(r[i].w)}; }
        const float a8[8] = {acc[0].x, acc[0].y, acc[1].x, acc[1].y, acc[2].x, acc[2].y, acc[3].x, acc[3].y};
        float b4[4], c2[2];
#pragma unroll
        for (int i = 0; i < 4; ++i) { const float keep = g4 ? a8[i + 4] : a8[i], send = g4 ? a8[i] : a8[i + 4]; b4[i] = keep + shx(send, 32, lane); }
#pragma unroll
        for (int i = 0; i < 2; ++i) { const float keep = g2b ? b4[i + 2] : b4[i], send = g2b ? b4[i] : b4[i + 2]; c2[i] = keep + shx(send, 16, lane); }
        const float keep = g1 ? c2[1] : c2[0], send = g1 ? c2[0] : c2[1];
        const float o = keep + shx(send, 8, lane);
        const int b = t / SEQ;
        Xout[(size_t)t * D + col] = Xin[(size_t)t * D + col] + g2[(size_t)b * 6144 + col] * o;
    }
}
struct PeerOwn { int first_slice, slice_step, t0, t1; };
__device__ __forceinline__ PeerOwn peer_own(unsigned* bar, unsigned x, unsigned rank, int wid) {
    unsigned nx = 0, px = 0, nloc = 1;
#pragma unroll
    for (unsigned jx = 0; jx < 16; ++jx) { const unsigned cnt = xb_ld(&bar[XB_XCNT(jx)]); if (jx == x) { px = nx; nloc = cnt ? cnt : 1u; } nx += cnt ? 1u : 0u; }
    if (rank >= nloc) rank = nloc - 1;
    const unsigned nw = nloc * (NT / 64), wr = rank * (NT / 64) + wid;
    PeerOwn o; o.first_slice = (int)px; o.slice_step = (int)(nx ? nx : 1u);
    o.t0 = (int)(((unsigned long long)wr * T) / nw); o.t1 = (int)(((unsigned long long)(wr + 1) * T) / nw);
    return o;
}

constexpr int LDS_MISC = pg8::STAGE_BYTES;
constexpr int LDS_BYTES = pg8::STAGE_BYTES + 256;
extern __shared__ __attribute__((aligned(16))) unsigned char smem[];
#ifndef PROBE_ID
#define PROBE_ID 0
#endif
__global__ void __launch_bounds__(NT, 2) mega_fwd(Params p) {
    unsigned char* lds = smem;
    PG8_LAS unsigned char* ldsl = (PG8_LAS unsigned char*)smem;
    volatile LAS unsigned* bst = (volatile LAS unsigned*)(smem + LDS_MISC);
    unsigned char* ws = p.ws;
    if (threadIdx.x == 0) { bst[0] = 0u; bst[1] = 0u; bst[2] = xb_add((unsigned*)(ws + WS_CTL) + XB_RANK(xb_xcc_id()), 1u); }
    __syncthreads();
    const XcdBarrier bar = xcd_barrier_post((unsigned*)(ws + WS_CTL), bst);
#define GRID_SYNC() xcd_barrier(bar)
#define PH_BEGIN(id) for (int _rep = 0; _rep < ((PROBE_ID) == (id) ? 3 : 1); ++_rep) {
#define PH_END() GRID_SYNC(); }
    const float* x = p.in[0]; const float* c = p.in[1]; const float* norm1_g = p.in[2]; const float* norm2_g = p.in[3];
    const float* w_mod = p.in[4]; const float* b_mod = p.in[5]; const float* conv_w_in = p.in[6]; const float* conv_w = p.in[7]; const float* conv_w_out = p.in[8];
    const float* pool_w_in = p.in[9]; const float* pool_w_grp = p.in[10]; const float* pool_scale = p.in[11]; const float* pool_w_out = p.in[12];
    const float* peer_w_q = p.in[13]; const float* peer_k1 = p.in[14]; const float* peer_k2 = p.in[15]; const float* peer_u = p.in[16]; const float* peer_v = p.in[17]; const float* final_g = p.in[18];
    bf16_t* U16 = (bf16_t*)(ws + WS_U16); bf16_t* V16 = (bf16_t*)(ws + WS_V16);
    bf16_t* Wci = (bf16_t*)(ws + WS_WCI); bf16_t* Wco = (bf16_t*)(ws + WS_WCO); bf16_t* Wpi = (bf16_t*)(ws + WS_WPI); bf16_t* Wpg = (bf16_t*)(ws + WS_WPG); bf16_t* Wpo = (bf16_t*)(ws + WS_WPO);
    bf16_t* Wq = (bf16_t*)(ws + WS_WQ); bf16_t* Kbd = (bf16_t*)(ws + WS_KBD);
    float* mod = (float*)(ws + WS_MOD);
    bf16_t* Hh = (bf16_t*)(ws + WS_HH); bf16_t* Bg = (bf16_t*)(ws + WS_BG); bf16_t* Vv = (bf16_t*)(ws + WS_VV); bf16_t* Aa = (bf16_t*)(ws + WS_AA);
    float* S = (float*)(ws + WS_HH);
    float* XA = (float*)(ws + WS_XA); bf16_t* H2 = (bf16_t*)(ws + WS_H2); bf16_t* Qq = (bf16_t*)(ws + WS_QQ);
    int* IDX = (int*)(ws + WS_IDX); float* GATE = (float*)(ws + WS_GATE);
    float* PART = (float*)(ws + WS_HH);
    float* Wg = (float*)(ws + WS_QQ);
    float* XB = p.out;
    const int G = gridDim.x;
    pg8::StaticOrder so;

    PH_BEGIN(1)
        constexpr int N_UV = 2 * NE * D / 16384;
        constexpr int I_U = 0, I_V = I_U + N_UV, I_KB = I_V + N_UV, I_CI = I_KB + 16, I_CO = I_CI + 48 * 16, I_PI = I_CO + 256, I_PG = I_PI + 256, I_PO = I_PG + 64,
                      I_WQ = I_PO + 256, I_MOD = I_WQ + 2 * 32 * 16, I_END = I_MOD + 192;
        float* cact = (float*)(lds + 32768);
        if ((int)blockIdx.x + ((I_END - I_MOD + G - 1) / G) * 0 >= 0) { const int tid = otid(); for (int i = tid; i < 8 * D; i += NT) { const float v = c[i]; cact[i] = v / (1.0f + __expf(-v)); } }
        __syncthreads();
        for (int w0 = blockIdx.x; w0 < I_END; w0 += G) {
            const int w = (w0 < 192) ? (I_MOD + w0) : (w0 - 192);
            if (w < I_V) cvt_sliced(peer_u, U16, w - I_U);
            else if (w < I_KB) cvt_sliced(peer_v, V16, w - I_V);
            else if (w < I_CI) kbd_item(peer_k1, peer_k2, Kbd, w - I_KB);
            else if (w < I_CO) { const int i = w - I_CI; transpose_tile<1>(conv_w_in, Wci, D, 3072, i % 48, i / 48, (float*)lds); }
            else if (w < I_PI) { const int i = w - I_CO; transpose_tile<0>(conv_w_out, Wco, D, D, i % 16, i / 16, (float*)lds); }
            else if (w < I_PG) { const int i = w - I_PI; transpose_tile<0>(pool_w_in, Wpi, D, D, i % 16, i / 16, (float*)lds); }
            else if (w < I_PO) { const int i = w - I_PG, g = i >> 4, j = i & 15; transpose_tile<0>(pool_w_grp + (size_t)g * 65536, Wpg + (size_t)g * 65536, 256, 256, j % 4, j / 4, (float*)lds); }
            else if (w < I_WQ) { const int i = w - I_PO; transpose_tile<0>(pool_w_out, Wpo, D, D, i % 16, i / 16, (float*)lds); }
            else if (w < I_MOD) { const int i = w - I_WQ, l = i >> 9, j = i & 511; transpose_tile<0>(peer_w_q + (size_t)l * D * 2048, Wq + (size_t)l * 2048 * D, D, 2048, j % 32, j / 32, (float*)lds); }
            else mod_item(cact, w_mod, b_mod, mod, w - I_MOD, (float*)lds);
        }
    PH_END()

    const float* xin = x;
    for (int l = 0; l < 2; ++l) {
        const float* ml = mod + (size_t)l * 8 * 6144;
        float* x1 = XA; float* x2 = XB;
        PH_BEGIN(2) { const int tid = otid(); for (int r = blockIdx.x * 8 + (tid >> 6); r < T; r += G * 8) rmsnorm_row<0>(xin, norm1_g + l * D, ml + 0, ml + 1024, Hh, nullptr, r, tid & 63); } PH_END()
        if (l == 0) {
            PH_BEGIN(3) so.init(T, 3072, G, blockIdx.x); pg8::gemm_phase(ldsl, pg8::Gemm{Hh, Wci, D, D, D, 0}, so, EpiConvIn{Bg, Vv}); PH_END()
            PH_BEGIN(4) for (size_t i = (size_t)blockIdx.x * NT + otid(); i < (size_t)T * D / 4; i += (size_t)G * NT) conv_elem(Bg, Vv, conv_w, Aa, i); PH_END()
            PH_BEGIN(3) so.init(T, D, G, blockIdx.x); pg8::gemm_phase(ldsl, pg8::Gemm{Aa, Wco, D, D, D, 0}, so, EpiResid{xin, x1, ml + 2048}); PH_END()
        } else {
            PH_BEGIN(3) so.init(T, D, G, blockIdx.x); pg8::gemm_phase(ldsl, pg8::Gemm{Hh, Wpi, D, D, D, 0}, so, EpiBf16{Bg, D, 0}); PH_END()
            PH_BEGIN(4) for (size_t i = (size_t)blockIdx.x * NT + otid(); i < (size_t)T * D / 4; i += (size_t)G * NT) pool_elem(Bg, Vv, i); PH_END()
            PH_BEGIN(3) so.init(T, D, G, blockIdx.x); pg8::gemm_phase(ldsl, pg8::Gemm{Vv, Wpg, D, 256, 256, 512}, so, EpiScaleBf16{Aa, pool_scale, D, 0}); PH_END()
            PH_BEGIN(3) so.init(T, D, G, blockIdx.x); pg8::gemm_phase(ldsl, pg8::Gemm{Aa, Wpo, D, D, D, 0}, so, EpiResid{xin, x1, ml + 2048}); PH_END()
        }
        PH_BEGIN(2) { const int tid = otid(); for (int r = blockIdx.x * 8 + (tid >> 6); r < T; r += G * 8) rmsnorm_row<0>(x1, norm2_g + l * D, ml + 3072, ml + 4096, H2, nullptr, r, tid & 63); } PH_END()
        PH_BEGIN(3) so.init(T, 2048, G, blockIdx.x); pg8::gemm_phase(ldsl, pg8::Gemm{H2, Wq + (size_t)l * 2048 * D, D, D, D, 0}, so, EpiBf16{Qq, 2048, 0}); PH_END()
        PH_BEGIN(5) so.init(T * 8, 256, G, blockIdx.x); pg8::gemm_phase(ldsl, pg8::Gemm{Qq, Kbd + (size_t)l * 65536, 256, 256, 256, 0}, so, EpiF32{S, 256, 0}); PH_END()
        PH_BEGIN(6) for (size_t pi = (size_t)blockIdx.x * NT + otid(); pi < (size_t)T * 8; pi += (size_t)G * NT) topk_pair(S, IDX, GATE, pi); PH_END()
        PH_BEGIN(7) {
            const int tid = otid(), lane = tid & 63;
            const PeerOwn own = peer_own(bar.bar, bar.x, bst[2], tid >> 6);
            for (int sl = own.first_slice; sl < 16; sl += own.slice_step)
                peer_u_tokens(H2, IDX, (const unsigned char*)U16 + ((size_t)l * 16 + sl) * NE * 128, PART + (size_t)sl * T * NSEL, sl, own.t0, own.t1, lane);
        } PH_END()
        PH_BEGIN(8) for (size_t i = (size_t)blockIdx.x * NT + otid(); i < (size_t)T * NSEL / 4; i += (size_t)G * NT) {
            float4 a = ((const float4*)PART)[i];
#pragma unroll
            for (int sl = 1; sl < 16; ++sl) { const float4 q = ((const float4*)(PART + (size_t)sl * T * NSEL))[i]; a.x += q.x; a.y += q.y; a.z += q.z; a.w += q.w; }
            const float4 gt = ((const float4*)GATE)[i]; float4 o;
            o.x = gt.x * 0.5f * a.x * (1.0f + erff(a.x * 0.70710678118654752f)); o.y = gt.y * 0.5f * a.y * (1.0f + erff(a.y * 0.70710678118654752f));
            o.z = gt.z * 0.5f * a.z * (1.0f + erff(a.z * 0.70710678118654752f)); o.w = gt.w * 0.5f * a.w * (1.0f + erff(a.w * 0.70710678118654752f));
            ((float4*)Wg)[i] = o;
        } PH_END()
        PH_BEGIN(9) {
            const int tid = otid(), lane = tid & 63;
            const PeerOwn own = peer_own(bar.bar, bar.x, bst[2], tid >> 6);
            for (int sl = own.first_slice; sl < 16; sl += own.slice_step)
                peer_v_tokens(Wg, IDX, (const unsigned char*)V16 + ((size_t)l * 16 + sl) * NE * 128, x1, ml + 5120, x2, sl, own.t0, own.t1, lane);
        } PH_END()
        xin = x2;
    }
    { const int tid = otid(); for (int r = blockIdx.x * 8 + (tid >> 6); r < T; r += G * 8) rmsnorm_row<1>(XB, final_g, nullptr, nullptr, nullptr, XB, r, tid & 63); }
}

extern "C" void kernel_launch(void* const* d_in, const int* in_sizes, int n_in, void* d_out, int out_size, void* d_ws, size_t ws_size, hipStream_t stream) {
    static int grid = 0;
    if (grid == 0) {
        if (n_in != 19 || ws_size < WS_END) { fprintf(stderr, "kernel_launch: expected 19 inputs and >= %zu bytes of workspace (got %d, %zu)\n", (size_t)WS_END, n_in, ws_size); grid = -1; return; }
        int dev = 0, cus = 0, per_cu = 0;
        (void)hipGetDevice(&dev);
        (void)hipDeviceGetAttribute(&cus, hipDeviceAttributeMultiprocessorCount, dev);
        if (hipFuncSetAttribute((const void*)mega_fwd, hipFuncAttributeMaxDynamicSharedMemorySize, LDS_BYTES) != hipSuccess) { fprintf(stderr, "kernel_launch: cannot get %d bytes of dynamic LDS\n", LDS_BYTES); grid = -1; return; }
        (void)hipOccupancyMaxActiveBlocksPerMultiprocessor(&per_cu, (const void*)mega_fwd, NT, LDS_BYTES);
        if (per_cu < 1) { fprintf(stderr, "kernel_launch: occupancy query says %d blocks per CU\n", per_cu); grid = -1; return; }
        grid = cus;
        fprintf(stderr, "kernel_launch: %d CUs, occupancy query %d block(s) per CU, grid %d\n", cus, per_cu, grid);
    }
    if (grid < 0) return;
    (void)hipMemsetAsync((unsigned char*)d_ws + WS_CTL, 0, CTL_BYTES, stream);
    Params p{};
    for (int i = 0; i < 19; ++i) p.in[i] = (const float*)d_in[i];
    p.out = (float*)d_out; p.ws = (unsigned char*)d_ws;
    void* args[] = {&p};
    hipError_t e = hipLaunchCooperativeKernel((const void*)mega_fwd, dim3(grid), dim3(NT), args, LDS_BYTES, stream);
    if (e != hipSuccess) fprintf(stderr, "kernel_launch: cooperative launch failed: %s (grid %d)\n", hipGetErrorString(e), grid);
}
```

```cpp
#include <hip/hip_runtime.h>
#include <cstdio>
#include <cstdint>
#include <utility>

typedef unsigned short bf16_t;
typedef short bf16x8 __attribute__((ext_vector_type(8)));
typedef float f32x4 __attribute__((ext_vector_type(4)));
typedef float f32x2 __attribute__((ext_vector_type(2)));
typedef unsigned u32x2 __attribute__((ext_vector_type(2)));
constexpr int NT = 512;

constexpr int D = 1024, NB = 8, SEQ = 2048, T = NB * SEQ;
constexpr int NE = 16384, NH = 8, TOPK = 16, NSEL = NH * TOPK;
constexpr float EPS = 1e-6f;

__device__ __forceinline__ unsigned f2bf(float f) { unsigned u = __builtin_bit_cast(unsigned, f); return (u + 0x7fffu + ((u >> 16) & 1u)) >> 16; }
__device__ __forceinline__ unsigned pk2(float lo, float hi) { return f2bf(lo) | (f2bf(hi) << 16); }
__device__ __forceinline__ float bf_lo(unsigned u) { return __builtin_bit_cast(float, u << 16); }
__device__ __forceinline__ float bf_hi(unsigned u) { return __builtin_bit_cast(float, u & 0xffff0000u); }
__device__ __forceinline__ int otid() { int t = threadIdx.x; asm volatile("" : "+v"(t)); return t; }
__device__ __forceinline__ const float* ld_uniform_ptr(const unsigned char* tab, int i) {
    const unsigned long long v = ((const unsigned long long*)tab)[i];
    const unsigned lo = __builtin_amdgcn_readfirstlane((unsigned)v), hi = __builtin_amdgcn_readfirstlane((unsigned)(v >> 32));
    return (const float*)(((unsigned long long)hi << 32) | lo);
}
__device__ __forceinline__ float shx(float v, int m, int lane) { return __builtin_bit_cast(float, __builtin_amdgcn_ds_bpermute((lane ^ m) << 2, __builtin_bit_cast(int, v))); }
__device__ __forceinline__ float wave_sum(float v, int lane) {
#pragma unroll
    for (int o = 32; o > 0; o >>= 1) v += shx(v, o, lane);
    return v;
}

#define XB_TMO      128
#define XB_XCNT(j)  (256  + 64 * (j))
#define XB_XSUB(j)  (1280 + 64 * (j))
#define XB_XGEN(j)  (2304 + 64 * (j))
#define XB_TOP      3328
#define XB_TOPGEN   3392
#define XCD_BAR_WORDS 3456
#define XB_RANK(j)  (3584 + 64 * (j))
#define CTL_BYTES 32768
#define PTAB_OFF 24576
#define XB_SPIN_CAP (1u << 18)
#define LAS __attribute__((address_space(3)))
__device__ __forceinline__ unsigned xb_ld(unsigned* p)              { return __hip_atomic_load(p, __ATOMIC_RELAXED, __HIP_MEMORY_SCOPE_AGENT); }
__device__ __forceinline__ unsigned xb_add(unsigned* p, unsigned v) { return __hip_atomic_fetch_add(p, v, __ATOMIC_RELAXED, __HIP_MEMORY_SCOPE_AGENT); }
__device__ __forceinline__ unsigned xb_xcc_id() { return (unsigned)__builtin_amdgcn_s_getreg((3 << 11) | 20) & 0xFu; }
#define XB_SPIN(cond, bar) do { unsigned _sp = 0; while (cond) { __builtin_amdgcn_s_sleep(1); \
    if ((++_sp & 255u) == 0u) { if (xb_ld(&(bar)[XB_TMO])) break; if (_sp > XB_SPIN_CAP) { atomicAdd(&(bar)[XB_TMO], 1u); break; } } } } while (0)
struct XcdBarrier { unsigned* bar; unsigned x; volatile LAS unsigned* st; };
__device__ __forceinline__ XcdBarrier xcd_barrier_post(unsigned* bar, volatile LAS unsigned* st) {
    XcdBarrier b; b.bar = bar; b.x = xb_xcc_id(); b.st = st;
    if (threadIdx.x == 0) (void)xb_add(&bar[XB_XCNT(b.x)], 1u);
    return b;
}
__device__ __forceinline__ void xcd_barrier_complete(unsigned* bar, unsigned x, unsigned& nloc, unsigned& nx) {
    const unsigned G = gridDim.x * gridDim.y * gridDim.z;
    unsigned sum, cnt, mine, sp = 0u;
    for (;;) {
        sum = 0u; cnt = 0u; mine = 0u;
#pragma unroll
        for (unsigned j = 0; j < 16; ++j) { const unsigned c = xb_ld(&bar[XB_XCNT(j)]); sum += c; cnt += (c > 0u) ? 1u : 0u; mine = (j == x) ? c : mine; }
        if (sum == G) break;
        __builtin_amdgcn_s_sleep(1);
        if ((++sp & 255u) == 0u) { if (xb_ld(&bar[XB_TMO])) break; if (sp > XB_SPIN_CAP) { atomicAdd(&bar[XB_TMO], 1u); break; } }
    }
    nloc = mine > 0u ? mine : 1u; nx = cnt > 0u ? cnt : 1u;
}
__device__ __forceinline__ void xcd_barrier(const XcdBarrier& b) {
    asm volatile("s_waitcnt vmcnt(0)" ::: "memory");
    __syncthreads();
    if (threadIdx.x == 0) {
        unsigned* bar = b.bar;
        __builtin_amdgcn_s_waitcnt(0);
        unsigned nloc = b.st[0], nx = b.st[1];
        if (nloc == 0u) { xcd_barrier_complete(bar, b.x, nloc, nx); b.st[0] = nloc; b.st[1] = nx; }
        const unsigned old = xb_add(&bar[XB_XSUB(b.x)], 1u);
        const unsigned gen = old / nloc;
        if (old + 1u == (gen + 1u) * nloc) {
            __builtin_amdgcn_fence(__ATOMIC_RELEASE, "agent");
            asm volatile("s_waitcnt vmcnt(0)" ::: "memory");
            const unsigned og = xb_add(&bar[XB_TOP], 1u);
            const unsigned tg = og / nx;
            if (og + 1u == (tg + 1u) * nx) xb_add(&bar[XB_TOPGEN], 1u);
            else XB_SPIN(xb_ld(&bar[XB_TOPGEN]) == tg, bar);
            __builtin_amdgcn_fence(__ATOMIC_ACQUIRE, "agent");
            xb_add(&bar[XB_XGEN(b.x)], 1u);
            asm volatile("s_waitcnt vmcnt(0)" ::: "memory");
        } else {
            XB_SPIN(xb_ld(&bar[XB_XGEN(b.x)]) == gen, bar);
            __builtin_amdgcn_fence(__ATOMIC_ACQUIRE, "agent");
            asm volatile("s_waitcnt vmcnt(0)" ::: "memory");
        }
    }
    __syncthreads();
}

namespace pg8 {
#define PG8_LAS __attribute__((address_space(3)))
constexpr int BM = 256, BK = 64, HALF = 128, HTB = HALF * BK * 2  , STAGE_BYTES = 8 * HTB, NXCD = 8, WGM = 8;
__host__ __device__ __forceinline__ int lds_byte(int r, int c) { const int st = (r >> 4) * 2 + (c >> 5), rr = r & 15, cc = c & 31, ob = rr * 64 + cc * 2; return st * 1024 + (ob ^ (((ob >> 9) & 1) << 5)); }
__host__ __device__ __forceinline__ void stage_rc(int b, int& R, int& C) { const int st = b / 1024, sb = b % 1024, swz = sb ^ (((sb >> 9) & 1) << 5); R = (st >> 1) * 16 + swz / 64; C = (st & 1) * 32 + (swz % 64) / 2; }
__host__ __device__ __forceinline__ int perm32(int rho) { const int n = rho >> 4, i = rho & 15; return 8 * (i >> 2) + 4 * n + (i & 3); }

struct Unit { int pm, pn; };
struct Gemm { const bf16_t* A; const bf16_t* Bt; int lda, ldb, K, a_colstep; };
struct StaticOrder {
    int nM, nN, nwg, G, c;
    __host__ __device__ void init(int M, int N, int G_, int c_) { nM = M / BM; nN = N / BM; nwg = nM * nN; G = G_; c = c_; }
    __host__ __device__ bool next(int i, Unit& u) const {
        const long L = (long)i * G + c; if (L >= nwg) return false;
        int wgid = (int)L; { const int q = nwg / NXCD, r = nwg % NXCD, xcd = wgid % NXCD, off = wgid / NXCD; wgid = (xcd < r ? xcd * (q + 1) : r * (q + 1) + (xcd - r) * q) + off; }
        const int nig = WGM * nN, gid = wgid / nig, fm = gid * WGM, gsz = (nM - fm) < WGM ? (nM - fm) : WGM;
        u.pm = fm + ((wgid % nig) % gsz); u.pn = (wgid % nig) / gsz; return true;
    }
    __device__ __forceinline__ void a_ready(const Unit&) const {}
    __device__ __forceinline__ void done(const Unit&) const {}
};
template <class Epi, class Sched>
__device__ __forceinline__ void gemm_phase(PG8_LAS unsigned char* lds, const Gemm g, const Sched& S, const Epi& E) {
    const int tid = otid(), wid = __builtin_amdgcn_readfirstlane(tid >> 6), lane = tid & 63, wr = wid >> 2, wc = wid & 3, fr = lane & 15, fq = lane >> 4;
    const int K = g.K, nt = K / BK;
    unsigned voffA[2], voffB[2];
#pragma unroll
    for (int i = 0; i < 2; ++i) { int R, C; stage_rc(tid * 16 + i * 8192, R, C); const int Rb = Epi::PERM ? ((R & ~31) + perm32(R & 31)) : R;
        voffA[i] = (unsigned)(R * g.lda + C) * 2u; voffB[i] = (unsigned)(Rb * g.ldb + C) * 2u; }
    const size_t kstep = (size_t)(BK * 2);
    const size_t hstepA = (size_t)HALF * g.lda * 2, hstepB = (size_t)HALF * g.ldb * 2;
    const size_t tstepA = 2 * hstepA, tstepB = 2 * hstepB;
    const size_t acs = (size_t)g.a_colstep;
    const unsigned ldsw = (unsigned)wid * 1024u;
    const int aoff = lds_byte(wr * 64 + fr, fq * 8), boff = lds_byte(wc * 32 + fr, fq * 8);
#define PG8_SA(b, h) (((b) * 2 + (h)) * HTB)
#define PG8_SB(b, h) ((4 + (b) * 2 + (h)) * HTB)
#define PG8_STAGE(bufoff, gbase, voff) do { _Pragma("unroll") for (int _i = 0; _i < 2; ++_i) \
        __builtin_amdgcn_global_load_lds((const unsigned*)((const char*)(gbase) + (voff)[_i]), (PG8_LAS unsigned*)(lds + (bufoff) + ldsw + _i * 8192), 16, 0, 0); } while (0)
#define PG8_LDA(dst, b, h) do { _Pragma("unroll") for (int m = 0; m < 4; ++m) _Pragma("unroll") for (int k = 0; k < 2; ++k) dst[m][k] = *(const PG8_LAS bf16x8*)(lds + PG8_SA(b, h) + aoff + m * 2048 + k * 1024); } while (0)
#define PG8_LDB(dst, b, h) do { _Pragma("unroll") for (int n = 0; n < 2; ++n) _Pragma("unroll") for (int k = 0; k < 2; ++k) dst[n][k] = *(const PG8_LAS bf16x8*)(lds + PG8_SB(b, h) + boff + n * 2048 + k * 1024); } while (0)
#define PG8_MMA(ai, bj, At, Bt) do { __builtin_amdgcn_s_setprio(1); _Pragma("unroll") for (int m = 0; m < 4; ++m) _Pragma("unroll") for (int n = 0; n < 2; ++n) _Pragma("unroll") for (int k = 0; k < 2; ++k) \
        acc[ai][bj][m][n] = __builtin_amdgcn_mfma_f32_16x16x32_bf16(Bt[n][k], At[m][k], acc[ai][bj][m][n], 0, 0, 0); __builtin_amdgcn_s_setprio(0); } while (0)
#define PG8_WAIT_V(n) asm volatile("s_waitcnt vmcnt(" #n ")" ::: "memory")
#define PG8_WAIT_L(n) asm volatile("s_waitcnt lgkmcnt(" #n ")" ::: "memory")
#define PG8_BAR __builtin_amdgcn_s_barrier()
#define PG8_SCHED __builtin_amdgcn_sched_barrier(0)
    Unit cur, nxt; int ui = 0;
    if (!S.next(0, cur)) return;
    f32x4 acc[2][2][4][2];
#pragma unroll
    for (int a = 0; a < 2; ++a)
#pragma unroll
        for (int b = 0; b < 2; ++b)
#pragma unroll
            for (int m = 0; m < 4; ++m)
#pragma unroll
                for (int n = 0; n < 2; ++n) acc[a][b][m][n] = (f32x4){0.f, 0.f, 0.f, 0.f};
    bf16x8 At[4][2], B0[2][2], B1[2][2];
    const char* cA = (const char*)g.A + (size_t)cur.pm * tstepA + (size_t)cur.pn * acs; const char* cB = (const char*)g.Bt + (size_t)cur.pn * tstepB;
    S.a_ready(cur);
    PG8_STAGE(PG8_SB(0, 0), cB, voffB); PG8_STAGE(PG8_SA(0, 0), cA, voffA); PG8_STAGE(PG8_SB(0, 1), cB + hstepB, voffB); PG8_STAGE(PG8_SA(0, 1), cA + hstepA, voffA);
    if (wr == 1) PG8_BAR;
    PG8_WAIT_V(4); PG8_BAR;
    PG8_STAGE(PG8_SB(1, 0), cB + kstep, voffB); PG8_STAGE(PG8_SA(1, 0), cA + kstep, voffA); PG8_STAGE(PG8_SB(1, 1), cB + hstepB + kstep, voffB);
    PG8_WAIT_V(6); PG8_BAR;
    for (;;) {
        const bool has_next = S.next(ui + 1, nxt);
        const char* nA = has_next ? (const char*)g.A + (size_t)nxt.pm * tstepA + (size_t)nxt.pn * acs : cA; const char* nB = has_next ? (const char*)g.Bt + (size_t)nxt.pn * tstepB : cB;
        for (int t = 0; t < nt; t += 2) {
            const bool last = (t == nt - 2);
            const char* a1 = cA + (size_t)(t + 1) * kstep;
            const char* a2 = last ? nA : cA + (size_t)(t + 2) * kstep; const char* b2 = last ? nB : cB + (size_t)(t + 2) * kstep;
            const char* a3 = a2 + kstep; const char* b3 = b2 + kstep;
            if (last && has_next) S.a_ready(nxt);
            PG8_LDB(B0, 0, 0); PG8_SCHED; PG8_LDA(At, 0, 0); PG8_STAGE(PG8_SA(1, 1), a1 + hstepA, voffA);
            PG8_WAIT_L(8); PG8_BAR; PG8_WAIT_L(0); PG8_MMA(0, 0, At, B0); PG8_BAR; PG8_SCHED;
            PG8_LDB(B1, 0, 1); PG8_STAGE(PG8_SB(0, 0), b2, voffB);
            PG8_BAR; PG8_WAIT_L(0); PG8_MMA(0, 1, At, B1); PG8_BAR;
            PG8_LDA(At, 0, 1); PG8_STAGE(PG8_SA(0, 0), a2, voffA);
            PG8_BAR; PG8_WAIT_L(0); PG8_MMA(1, 0, At, B0); PG8_BAR; PG8_SCHED;
            PG8_STAGE(PG8_SB(0, 1), b2 + hstepB, voffB);
            PG8_WAIT_V(6); PG8_BAR; PG8_MMA(1, 1, At, B1); PG8_BAR;
            PG8_LDB(B0, 1, 0); PG8_SCHED; PG8_LDA(At, 1, 0); PG8_STAGE(PG8_SA(0, 1), a2 + hstepA, voffA);
            PG8_WAIT_L(8); PG8_BAR; PG8_WAIT_L(0); PG8_MMA(0, 0, At, B0); PG8_BAR; PG8_SCHED;
            PG8_LDB(B1, 1, 1); PG8_STAGE(PG8_SB(1, 0), b3, voffB);
            PG8_BAR; PG8_WAIT_L(0); PG8_MMA(0, 1, At, B1); PG8_BAR;
            PG8_LDA(At, 1, 1); PG8_STAGE(PG8_SA(1, 0), a3, voffA);
            PG8_BAR; PG8_WAIT_L(0); PG8_MMA(1, 0, At, B0); PG8_BAR; PG8_SCHED;
            PG8_STAGE(PG8_SB(1, 1), b3 + hstepB, voffB);
            PG8_WAIT_V(6); PG8_BAR; PG8_MMA(1, 1, At, B1); PG8_BAR;
        }
            if constexpr (!Epi::AFTER_DRAIN) { int te = tid; asm volatile("" : "+v"(te));
            const int we = __builtin_amdgcn_readfirstlane(te >> 6), le = te & 63; E(acc, cur, we >> 2, we & 3, le & 15, le >> 4); S.done(cur); }
            if (!has_next) break;
#pragma unroll
        for (int a = 0; a < 2; ++a)
#pragma unroll
            for (int b = 0; b < 2; ++b)
#pragma unroll
                for (int m = 0; m < 4; ++m)
#pragma unroll
                    for (int n = 0; n < 2; ++n) acc[a][b][m][n] = (f32x4){0.f, 0.f, 0.f, 0.f};
        cur = nxt; cA = nA; cB = nB; ++ui;
    }
    PG8_WAIT_V(0);
    if (wr == 0) PG8_BAR;
    PG8_BAR;
    if constexpr (Epi::AFTER_DRAIN) { E.fused(acc, cur, wr, wc, fr, fq, lds, wid, lane); S.done(cur); }
#undef PG8_SA
#undef PG8_SB
#undef PG8_STAGE
#undef PG8_LDA
#undef PG8_LDB
#undef PG8_MMA
#undef PG8_WAIT_V
#undef PG8_WAIT_L
#undef PG8_BAR
#undef PG8_SCHED
}
}

using pg8::Unit;
struct EpiBf16 {
    static constexpr bool PERM = false, AFTER_DRAIN = false;
    bf16_t* O; int ldc; int pad;
    __device__ __forceinline__ void operator()(const f32x4 (&acc)[2][2][4][2], const Unit& u, int wr, int wc, int fr, int fq) const {
        const int row0 = u.pm * 256 + wr * 64 + fr, col0 = u.pn * 256 + wc * 32 + 4 * fq;
#pragma unroll
        for (int ai = 0; ai < 2; ++ai)
#pragma unroll
            for (int m = 0; m < 4; ++m) { bf16_t* rowp = O + (size_t)(row0 + ai * 128 + m * 16) * ldc + col0;
#pragma unroll
                for (int bj = 0; bj < 2; ++bj)
#pragma unroll
                    for (int n = 0; n < 2; ++n) { const f32x4 v = acc[ai][bj][m][n]; u32x2 o; o.x = pk2(v[0], v[1]); o.y = pk2(v[2], v[3]); *(u32x2*)(rowp + bj * 128 + n * 16) = o; } }
    }
};
struct EpiF32 {
    static constexpr bool PERM = false, AFTER_DRAIN = false;
    float* O; int ldc; int pad;
    __device__ __forceinline__ void operator()(const f32x4 (&acc)[2][2][4][2], const Unit& u, int wr, int wc, int fr, int fq) const {
        const int row0 = u.pm * 256 + wr * 64 + fr, col0 = u.pn * 256 + wc * 32 + 4 * fq;
#pragma unroll
        for (int ai = 0; ai < 2; ++ai)
#pragma unroll
            for (int m = 0; m < 4; ++m) { float* rowp = O + (size_t)(row0 + ai * 128 + m * 16) * ldc + col0;
#pragma unroll
                for (int bj = 0; bj < 2; ++bj)
#pragma unroll
                    for (int n = 0; n < 2; ++n) *(f32x4*)(rowp + bj * 128 + n * 16) = acc[ai][bj][m][n]; }
    }
};
struct EpiScaleBf16 {
    static constexpr bool PERM = false, AFTER_DRAIN = false;
    bf16_t* O; const float* scale; int ldc; int pad;
    __device__ __forceinline__ void operator()(const f32x4 (&acc)[2][2][4][2], const Unit& u, int wr, int wc, int fr, int fq) const {
        const int row0 = u.pm * 256 + wr * 64 + fr, col0 = u.pn * 256 + wc * 32 + 4 * fq;
        f32x4 sv[2][2];
#pragma unroll
        for (int bj = 0; bj < 2; ++bj)
#pragma unroll
            for (int n = 0; n < 2; ++n) sv[bj][n] = *(const f32x4*)(scale + col0 + bj * 128 + n * 16);
#pragma unroll
        for (int ai = 0; ai < 2; ++ai)
#pragma unroll
            for (int m = 0; m < 4; ++m) { bf16_t* rowp = O + (size_t)(row0 + ai * 128 + m * 16) * ldc + col0;
#pragma unroll
                for (int bj = 0; bj < 2; ++bj)
#pragma unroll
                    for (int n = 0; n < 2; ++n) { const f32x4 v = acc[ai][bj][m][n] * sv[bj][n]; u32x2 o; o.x = pk2(v[0], v[1]); o.y = pk2(v[2], v[3]); *(u32x2*)(rowp + bj * 128 + n * 16) = o; } }
    }
};
struct EpiResid {
    static constexpr bool PERM = false, AFTER_DRAIN = false;
    const float* Xin; float* Xout; const float* gate;
    __device__ __forceinline__ void operator()(const f32x4 (&acc)[2][2][4][2], const Unit& u, int wr, int wc, int fr, int fq) const {
        const int row0 = u.pm * 256 + wr * 64 + fr, col0 = u.pn * 256 + wc * 32 + 4 * fq, b = (u.pm * 256) / SEQ;
        f32x4 gv[2][2];
#pragma unroll
        for (int bj = 0; bj < 2; ++bj)
#pragma unroll
            for (int n = 0; n < 2; ++n) gv[bj][n] = *(const f32x4*)(gate + (size_t)b * 6144 + col0 + bj * 128 + n * 16);
#pragma unroll
        for (int ai = 0; ai < 2; ++ai)
#pragma unroll
            for (int m = 0; m < 4; ++m) { const size_t ro = (size_t)(row0 + ai * 128 + m * 16) * D + col0;
#pragma unroll
                for (int bj = 0; bj < 2; ++bj)
#pragma unroll
                    for (int n = 0; n < 2; ++n) { const f32x4 xi = *(const f32x4*)(Xin + ro + bj * 128 + n * 16); *(f32x4*)(Xout + ro + bj * 128 + n * 16) = xi + gv[bj][n] * acc[ai][bj][m][n]; } }
    }
};
struct EpiConvIn {
    static constexpr bool PERM = false, AFTER_DRAIN = false;
    bf16_t* Bg; bf16_t* Vv;
    __device__ __forceinline__ void operator()(const f32x4 (&acc)[2][2][4][2], const Unit& u, int wr, int wc, int fr, int fq) const {
        const int row0 = u.pm * 256 + wr * 64 + fr, colt = u.pn * 256;
        if (colt < 1024) {
            const int col0 = colt + wc * 32 + 4 * fq;
#pragma unroll
            for (int ai = 0; ai < 2; ++ai)
#pragma unroll
                for (int m = 0; m < 4; ++m) { bf16_t* rowp = Bg + (size_t)(row0 + ai * 128 + m * 16) * D + col0;
#pragma unroll
                    for (int bj = 0; bj < 2; ++bj)
#pragma unroll
                        for (int n = 0; n < 2; ++n) { const f32x4 v = acc[ai][bj][m][n]; u32x2 o; o.x = pk2(v[0], v[1]); o.y = pk2(v[2], v[3]); *(u32x2*)(rowp + bj * 128 + n * 16) = o; } }
        } else {
            const int g0 = (colt - 1024) / 32 + wc;
#pragma unroll
            for (int ai = 0; ai < 2; ++ai)
#pragma unroll
                for (int m = 0; m < 4; ++m) { bf16_t* rowp = Vv + (size_t)(row0 + ai * 128 + m * 16) * D + 4 * fq;
#pragma unroll
                    for (int bj = 0; bj < 2; ++bj) { const f32x4 v = acc[ai][bj][m][0] * acc[ai][bj][m][1]; u32x2 o; o.x = pk2(v[0], v[1]); o.y = pk2(v[2], v[3]);
                        *(u32x2*)(rowp + (g0 + 4 * bj) * 16) = o; } }
        }
    }
};

constexpr size_t al256(size_t x) { return (x + 255) & ~(size_t)255; }
constexpr size_t WS_CTL  = 0;
constexpr size_t WS_U16  = al256(WS_CTL + CTL_BYTES);
constexpr size_t WS_V16  = WS_U16 + (size_t)2 * NE * D;
constexpr size_t WS_USC  = WS_V16 + (size_t)2 * NE * D;
constexpr size_t WS_VSC  = WS_USC + (size_t)2 * NE * 4;
constexpr size_t WS_WCI  = WS_VSC + (size_t)2 * NE * 4;
constexpr size_t WS_WCO  = WS_WCI + (size_t)3072 * D * 2;
constexpr size_t WS_WPI  = WS_WCO + (size_t)D * D * 2;
constexpr size_t WS_WPG  = WS_WPI + (size_t)D * D * 2;
constexpr size_t WS_WPO  = WS_WPG + (size_t)4 * 256 * 256 * 2;
constexpr size_t WS_WQ   = WS_WPO + (size_t)D * D * 2;
constexpr size_t WS_KBD  = WS_WQ + (size_t)2 * 2048 * D * 2;
constexpr size_t WS_MOD  = WS_KBD + (size_t)2 * 256 * 256 * 2;
constexpr size_t WS_HH   = al256(WS_MOD + (size_t)2 * 8 * 6144 * 4);
constexpr size_t WS_BG   = WS_HH + (size_t)T * D * 2;
constexpr size_t WS_VV   = WS_BG + (size_t)T * D * 2;
constexpr size_t WS_AA   = WS_VV + (size_t)T * D * 2;
constexpr size_t WS_XA   = WS_AA + (size_t)T * D * 2;
constexpr size_t WS_H2   = WS_XA + (size_t)T * D * 4;
constexpr size_t WS_QQ   = WS_H2 + (size_t)T * D * 2;
constexpr size_t WS_IDX  = WS_QQ + (size_t)T * 2048 * 2;
constexpr size_t WS_GATE = WS_IDX + (size_t)T * NSEL * 4;
constexpr size_t WS_END  = WS_GATE + (size_t)T * NSEL * 4;

struct Params { const float* in[19]; float* out; unsigned char* ws; };

template <int MODE>
__device__ __forceinline__ void transpose_tile(const float* __restrict__ W, bf16_t* __restrict__ Wt, int K, int N, int tn, int tk, float* tile  ) {
    const int tid = otid(), n0 = tn * 64, k0 = tk * 64, tx = tid & 63, ty = tid >> 6;
#pragma unroll
    for (int i = 0; i < 8; ++i) tile[(ty + 8 * i) * 65 + tx] = W[(size_t)(k0 + ty + 8 * i) * N + n0 + tx];
    __syncthreads();
#pragma unroll
    for (int i = 0; i < 8; ++i) {
        int n = n0 + ty + 8 * i, p = n;
        if (MODE == 1 && n >= 1024) { const int j = (n - 1024) & 1023, isu = (n >= 2048); p = 1024 + (j >> 4) * 32 + isu * 16 + (j & 15); }
        Wt[(size_t)p * K + k0 + tx] = (bf16_t)f2bf(tile[tx * 65 + ty + 8 * i]);
    }
    __syncthreads();
}
__device__ __forceinline__ void cvt_rows_fp8(const float* __restrict__ src, unsigned char* __restrict__ dst, float* __restrict__ isc, int R0, int lane) {
    float4 v[2][4];
#pragma unroll
    for (int q = 0; q < 2; ++q)
#pragma unroll
        for (int i = 0; i < 4; ++i) v[q][i] = ((const float4*)(src + (size_t)(R0 + q) * D + lane * 16))[i];
#pragma unroll
    for (int q = 0; q < 2; ++q) {
        float m = 0.f;
#pragma unroll
        for (int i = 0; i < 4; ++i) m = fmaxf(m, fmaxf(fmaxf(fabsf(v[q][i].x), fabsf(v[q][i].y)), fmaxf(fabsf(v[q][i].z), fabsf(v[q][i].w))));
#pragma unroll
        for (int o = 32; o > 0; o >>= 1) m = fmaxf(m, shx(m, o, lane));
        const float ratio = m > 1e-30f ? 224.0f / m : 1.0f;
        const float sc = __builtin_bit_cast(float, __builtin_bit_cast(unsigned, ratio) & 0x7f800000u);
        int w[4];
#pragma unroll
        for (int i = 0; i < 4; ++i) { int t = 0; t = __builtin_amdgcn_cvt_pk_fp8_f32(v[q][i].x * sc, v[q][i].y * sc, t, false); t = __builtin_amdgcn_cvt_pk_fp8_f32(v[q][i].z * sc, v[q][i].w * sc, t, true); w[i] = t; }
        const int R = R0 + q, l = R >> 14, e = R & (NE - 1), sl = lane >> 3;
        *(int4*)(dst + (((size_t)(l * 8 + sl) * NE + e) << 7) + (lane & 7) * 16) = make_int4(w[0], w[1], w[2], w[3]);
        if (lane == 0) isc[R] = 1.0f / sc;
    }
}
__device__ __forceinline__ void kbd_item(const float* __restrict__ k1, const float* __restrict__ k2, bf16_t* __restrict__ Kbd, int item) {
    const int tid = otid(), l = item >> 3, r0 = (item & 7) * 32;
#pragma unroll
    for (int i = 0; i < 16; ++i) { const int e = i * NT + tid, n = r0 + (e >> 8), k = e & 255;
        float v = 0.f;
        if (n < 128) { if (k < 128) v = k1[((size_t)l * 128 + n) * 128 + k]; } else { if (k >= 128) v = k2[((size_t)l * 128 + n - 128) * 128 + k - 128]; }
        Kbd[((size_t)l * 256 + n) * 256 + k] = (bf16_t)f2bf(v); }
}
__device__ __forceinline__ void mod_item(const float* __restrict__ cact, const float* __restrict__ w_mod, const float* __restrict__ b_mod, float* __restrict__ mod, int item, float* red  ) {
    const int tid = otid(), l = item / 96, n0 = (item % 96) * 64, col = tid & 63, kg = tid >> 6;
    float acc[8] = {0, 0, 0, 0, 0, 0, 0, 0};
    const float* w = w_mod + (size_t)l * D * 6144 + (size_t)(kg * 128) * 6144 + n0 + col;
#pragma unroll 8
    for (int k = 0; k < 128; ++k) { const float wv = w[(size_t)k * 6144];
#pragma unroll
        for (int b = 0; b < 8; ++b) acc[b] += cact[b * D + kg * 128 + k] * wv; }
#pragma unroll
    for (int b = 0; b < 8; ++b) red[(kg * 8 + b) * 64 + col] = acc[b];
    __syncthreads();
    { const int b = tid >> 6, cc = tid & 63; float s = b_mod[l * 6144 + n0 + cc];
#pragma unroll
      for (int q = 0; q < 8; ++q) s += red[(q * 8 + b) * 64 + cc];
      mod[((size_t)l * 8 + b) * 6144 + n0 + cc] = s; }
    __syncthreads();
}

template <int MODE>
__device__ __forceinline__ void rmsnorm_row(const float* x, const float* __restrict__ g, const float* __restrict__ sh, const float* __restrict__ sc, bf16_t* ob, float* of, int row, int lane) {
    const int b = row / SEQ;
    const float4* xr = (const float4*)(x + (size_t)row * D);
    float4 v[4]; float ss = 0.f;
#pragma unroll
    for (int i = 0; i < 4; ++i) { v[i] = xr[lane + 64 * i]; ss += v[i].x * v[i].x + v[i].y * v[i].y + v[i].z * v[i].z + v[i].w * v[i].w; }
    ss = wave_sum(ss, lane);
    const float r = rsqrtf(ss * (1.0f / D) + EPS);
#pragma unroll
    for (int i = 0; i < 4; ++i) {
        const int c4 = lane + 64 * i; const float4 gg = ((const float4*)g)[c4];
        float4 y; y.x = v[i].x * r * gg.x; y.y = v[i].y * r * gg.y; y.z = v[i].z * r * gg.z; y.w = v[i].w * r * gg.w;
        if (MODE == 0) {
            const float4 s1 = ((const float4*)(sc + (size_t)b * 6144))[c4], s0 = ((const float4*)(sh + (size_t)b * 6144))[c4];
            y.x = y.x * (1.f + s1.x) + s0.x; y.y = y.y * (1.f + s1.y) + s0.y; y.z = y.z * (1.f + s1.z) + s0.z; y.w = y.w * (1.f + s1.w) + s0.w;
            uint2 o; o.x = pk2(y.x, y.y); o.y = pk2(y.z, y.w);
            ((uint2*)(ob + (size_t)row * D))[c4] = o;
        } else ((float4*)(of + (size_t)row * D))[c4] = y;
    }
}
__device__ __forceinline__ int ord_key(float f) { const int b = __builtin_bit_cast(int, f); return b >= 0 ? b : (b ^ 0x7fffffff); }
__device__ __forceinline__ float key_val(int k) { const int b = k >= 0 ? k : (k ^ 0x7fffffff); return __builtin_bit_cast(float, b); }
__device__ __forceinline__ void ce(int& hi, int& lo) { const int a = hi, b = lo; hi = a > b ? a : b; lo = a > b ? b : a; }
__device__ __forceinline__ void sort16_desc(int (&v)[16]) {
#pragma unroll
    for (int ks = 1; ks <= 4; ++ks)
#pragma unroll
        for (int js = ks - 1; js >= 0; --js)
#pragma unroll
            for (int i = 0; i < 16; ++i) { const int k = 1 << ks, j = 1 << js, l = i ^ j; if (l > i) { if ((i & k) == 0) ce(v[i], v[l]); else ce(v[l], v[i]); } }
}
__device__ __forceinline__ void merge16_desc(int (&a)[16], const int (&b)[16]) {
#pragma unroll
    for (int i = 0; i < 16; ++i) a[i] = a[i] > b[15 - i] ? a[i] : b[15 - i];
#pragma unroll
    for (int js = 3; js >= 0; --js)
#pragma unroll
        for (int i = 0; i < 16; ++i) { const int j = 1 << js, l = i ^ j; if (l > i) ce(a[i], a[l]); }
}
__host__ __device__ constexpr int cand_ij(int c) { int n = 0; for (int i = 0; i < 16; ++i) for (int j = 0; j < 16; ++j) if ((i + 1) * (j + 1) <= 16) { if (n == c) return i * 16 + j; ++n; } return -1; }
constexpr int NCAND = 50;
static_assert(cand_ij(NCAND - 1) >= 0 && cand_ij(NCAND) < 0, "candidate count");
template <int C> __device__ __forceinline__ void cand_step(const float (&v1)[16], const float (&v2)[16], int (&cur)[16], int (&run)[16]) {
    constexpr int ij = cand_ij(C), i = ij >> 4, j = ij & 15;
    cur[C & 15] = (ord_key(v1[i] + v2[j]) & ~255) | ij;
    if constexpr ((C & 15) == 15 || C == NCAND - 1) {
        if constexpr (C == NCAND - 1) {
#pragma unroll
            for (int q = (C & 15) + 1; q < 16; ++q) cur[q] = (int)0x80000000;
        }
        sort16_desc(cur);
        if constexpr (C == 15) {
#pragma unroll
            for (int q = 0; q < 16; ++q) run[q] = cur[q];
        } else merge16_desc(run, cur);
    }
}
template <int... C> __device__ __forceinline__ void cand_all(std::integer_sequence<int, C...>, const float (&v1)[16], const float (&v2)[16], int (&cur)[16], int (&run)[16]) { (cand_step<C>(v1, v2, cur, run), ...); }
__device__ __forceinline__ void top16_of_128(const float* __restrict__ s, int (&run)[16]) {
#pragma unroll 1
    for (int g = 0; g < 8; ++g) {
        int cur[16];
#pragma unroll
        for (int q = 0; q < 4; ++q) { const float4 v = ((const float4*)s)[g * 4 + q];
            cur[4 * q + 0] = (ord_key(v.x) & ~127) | (g * 16 + 4 * q + 0); cur[4 * q + 1] = (ord_key(v.y) & ~127) | (g * 16 + 4 * q + 1);
            cur[4 * q + 2] = (ord_key(v.z) & ~127) | (g * 16 + 4 * q + 2); cur[4 * q + 3] = (ord_key(v.w) & ~127) | (g * 16 + 4 * q + 3); }
        sort16_desc(cur);
        if (g == 0) {
#pragma unroll
            for (int i = 0; i < 16; ++i) run[i] = cur[i];
        } else merge16_desc(run, cur);
    }
}
__device__ __forceinline__ int lut16(const int (&p)[4], int i) {
    const int r = i >> 2; const int w = r == 0 ? p[0] : (r == 1 ? p[1] : (r == 2 ? p[2] : p[3]));
    return (w >> ((i & 3) * 8)) & 127;
}
__device__ __forceinline__ void conv_elem8(const bf16_t* __restrict__ Bg, const bf16_t* __restrict__ Vv, const float* __restrict__ cw, bf16_t* __restrict__ Aa, size_t i) {
    const int t = (int)(i >> 7), c8 = (int)(i & 127), s = t & (SEQ - 1);
    const uint4 b = ((const uint4*)Bg)[i], v2 = ((const uint4*)Vv)[i];
    const uint4 v1 = ((const uint4*)Vv)[s >= 1 ? i - 128 : i], v0 = ((const uint4*)Vv)[s >= 2 ? i - 256 : i];
    const float m1 = s >= 1 ? 1.f : 0.f, m0 = s >= 2 ? 1.f : 0.f;
    const float4 w0a = ((const float4*)cw)[2 * c8], w0b = ((const float4*)cw)[2 * c8 + 1], w1a = ((const float4*)(cw + D))[2 * c8], w1b = ((const float4*)(cw + D))[2 * c8 + 1],
                 w2a = ((const float4*)(cw + 2 * D))[2 * c8], w2b = ((const float4*)(cw + 2 * D))[2 * c8 + 1];
    uint4 o;
    o.x = pk2(bf_lo(b.x) * (m0 * w0a.x * bf_lo(v0.x) + m1 * w1a.x * bf_lo(v1.x) + w2a.x * bf_lo(v2.x)), bf_hi(b.x) * (m0 * w0a.y * bf_hi(v0.x) + m1 * w1a.y * bf_hi(v1.x) + w2a.y * bf_hi(v2.x)));
    o.y = pk2(bf_lo(b.y) * (m0 * w0a.z * bf_lo(v0.y) + m1 * w1a.z * bf_lo(v1.y) + w2a.z * bf_lo(v2.y)), bf_hi(b.y) * (m0 * w0a.w * bf_hi(v0.y) + m1 * w1a.w * bf_hi(v1.y) + w2a.w * bf_hi(v2.y)));
    o.z = pk2(bf_lo(b.z) * (m0 * w0b.x * bf_lo(v0.z) + m1 * w1b.x * bf_lo(v1.z) + w2b.x * bf_lo(v2.z)), bf_hi(b.z) * (m0 * w0b.y * bf_hi(v0.z) + m1 * w1b.y * bf_hi(v1.z) + w2b.y * bf_hi(v2.z)));
    o.w = pk2(bf_lo(b.w) * (m0 * w0b.z * bf_lo(v0.w) + m1 * w1b.z * bf_lo(v1.w) + w2b.z * bf_lo(v2.w)), bf_hi(b.w) * (m0 * w0b.w * bf_hi(v0.w) + m1 * w1b.w * bf_hi(v1.w) + w2b.w * bf_hi(v2.w)));
    ((uint4*)Aa)[i] = o;
}
template <int W>
__device__ __forceinline__ void pool_elem8(const bf16_t* __restrict__ Uu, bf16_t* __restrict__ Pp, int t, int c8  ) {
    const int s = t & (SEQ - 1);
    const size_t i = (size_t)t * 128 + c8;
    uint4 r[W];
#pragma unroll
    for (int k = 0; k < W; ++k) r[k] = ((const uint4*)Uu)[k <= s ? i - (size_t)k * 128 : i];
    float a[8] = {0, 0, 0, 0, 0, 0, 0, 0};
#pragma unroll
    for (int k = 0; k < W; ++k) { const float m = k <= s ? 1.f : 0.f;
        a[0] += m * bf_lo(r[k].x); a[1] += m * bf_hi(r[k].x); a[2] += m * bf_lo(r[k].y); a[3] += m * bf_hi(r[k].y); a[4] += m * bf_lo(r[k].z); a[5] += m * bf_hi(r[k].z); a[6] += m * bf_lo(r[k].w); a[7] += m * bf_hi(r[k].w); }
    const float inv = 1.0f / (float)(s + 1 < W ? s + 1 : W);
    uint4 o;
    o.x = pk2(a[0] * inv - bf_lo(r[0].x), a[1] * inv - bf_hi(r[0].x)); o.y = pk2(a[2] * inv - bf_lo(r[0].y), a[3] * inv - bf_hi(r[0].y));
    o.z = pk2(a[4] * inv - bf_lo(r[0].z), a[5] * inv - bf_hi(r[0].z)); o.w = pk2(a[6] * inv - bf_lo(r[0].w), a[7] * inv - bf_hi(r[0].w));
    ((uint4*)Pp)[i] = o;
}

__device__ __forceinline__ void topk_pair(const float* __restrict__ S, int* __restrict__ IDX, float* __restrict__ GATE, size_t p) {
    int k1[16], k2[16];
    top16_of_128(S + p * 256, k1);
    top16_of_128(S + p * 256 + 128, k2);
    float v1[16], v2[16]; int id1[4] = {0, 0, 0, 0}, id2[4] = {0, 0, 0, 0};
#pragma unroll
    for (int i = 0; i < 16; ++i) { v1[i] = key_val(k1[i] & ~127); v2[i] = key_val(k2[i] & ~127); id1[i >> 2] |= (k1[i] & 127) << ((i & 3) * 8); id2[i >> 2] |= (k2[i] & 127) << ((i & 3) * 8); }
    int run[16];
    { int cur[16]; cand_all(std::make_integer_sequence<int, NCAND>{}, v1, v2, cur, run); }
    float sc[16], e[16], sum = 0.f;
#pragma unroll
    for (int i = 0; i < 16; ++i) sc[i] = key_val(run[i] & ~255);
#pragma unroll
    for (int i = 0; i < 16; ++i) { e[i] = __expf(sc[i] - sc[0]); sum += e[i]; }
    const float inv = 1.0f / sum;
    int* io = IDX + p * 16; float* go = GATE + p * 16;
#pragma unroll
    for (int q = 0; q < 4; ++q) {
        int4 iv; float4 gv;
        { const int f = run[4 * q + 0] & 255; iv.x = lut16(id1, f >> 4) * 128 + lut16(id2, f & 15); gv.x = e[4 * q + 0] * inv; }
        { const int f = run[4 * q + 1] & 255; iv.y = lut16(id1, f >> 4) * 128 + lut16(id2, f & 15); gv.y = e[4 * q + 1] * inv; }
        { const int f = run[4 * q + 2] & 255; iv.z = lut16(id1, f >> 4) * 128 + lut16(id2, f & 15); gv.z = e[4 * q + 2] * inv; }
        { const int f = run[4 * q + 3] & 255; iv.w = lut16(id1, f >> 4) * 128 + lut16(id2, f & 15); gv.w = e[4 * q + 3] * inv; }
        ((int4*)io)[q] = iv; ((float4*)go)[q] = gv;
    }
}

#define LOAD_IDS16(id, p) { const int4 _a = (p)[0], _b = (p)[1], _c = (p)[2], _d = (p)[3]; id[0] = _a.x; id[1] = _a.y; id[2] = _a.z; id[3] = _a.w; id[4] = _b.x; id[5] = _b.y; id[6] = _b.z; id[7] = _b.w; \
    id[8] = _c.x; id[9] = _c.y; id[10] = _c.z; id[11] = _c.w; id[12] = _d.x; id[13] = _d.y; id[14] = _d.z; id[15] = _d.w; }
#define FP8X2(w, hi) __builtin_amdgcn_cvt_pk_f32_fp8((int)(w), hi)
__device__ __forceinline__ void peer_u_tokens(const bf16_t* __restrict__ H2, const int* __restrict__ IDX, const unsigned char* __restrict__ tab, float* __restrict__ PARTs, int s, int t0, int t1, int lane) {
    const int g = lane >> 3, j = lane & 7;
    const unsigned char* tb = tab + j * 16;
    const bool b4 = (j & 4) != 0, b2 = (j & 2) != 0, b1 = (j & 1) != 0;
    for (int t = t0; t < t1; ++t) {
        int id[16];
        LOAD_IDS16(id, (const int4*)(IDX + (size_t)t * NSEL + g * 16));
        const uint4 h0 = *(const uint4*)(H2 + (size_t)t * D + s * 128 + j * 16), h1 = *(const uint4*)(H2 + (size_t)t * D + s * 128 + j * 16 + 8);
        uint4 r[16];
#pragma unroll
        for (int i = 0; i < 16; ++i) r[i] = *(const uint4*)(tb + (unsigned)id[i] * 128u);
        const f32x2 hp[8] = {{bf_lo(h0.x), bf_hi(h0.x)}, {bf_lo(h0.y), bf_hi(h0.y)}, {bf_lo(h0.z), bf_hi(h0.z)}, {bf_lo(h0.w), bf_hi(h0.w)},
                             {bf_lo(h1.x), bf_hi(h1.x)}, {bf_lo(h1.y), bf_hi(h1.y)}, {bf_lo(h1.z), bf_hi(h1.z)}, {bf_lo(h1.w), bf_hi(h1.w)}};
        float a[16];
#pragma unroll
        for (int i = 0; i < 16; ++i) {
            f32x2 sacc = hp[0] * FP8X2(r[i].x, false);
            sacc += hp[1] * FP8X2(r[i].x, true); sacc += hp[2] * FP8X2(r[i].y, false); sacc += hp[3] * FP8X2(r[i].y, true);
            sacc += hp[4] * FP8X2(r[i].z, false); sacc += hp[5] * FP8X2(r[i].z, true); sacc += hp[6] * FP8X2(r[i].w, false); sacc += hp[7] * FP8X2(r[i].w, true);
            a[i] = sacc.x + sacc.y; }
        float b8[8], c4[4], d2[2];
#pragma unroll
        for (int i = 0; i < 8; ++i) { const float keep = b4 ? a[i + 8] : a[i], send = b4 ? a[i] : a[i + 8]; b8[i] = keep + shx(send, 4, lane); }
#pragma unroll
        for (int i = 0; i < 4; ++i) { const float keep = b2 ? b8[i + 4] : b8[i], send = b2 ? b8[i] : b8[i + 4]; c4[i] = keep + shx(send, 2, lane); }
#pragma unroll
        for (int i = 0; i < 2; ++i) { const float keep = b1 ? c4[i + 2] : c4[i], send = b1 ? c4[i] : c4[i + 2]; d2[i] = keep + shx(send, 1, lane); }
        *(float2*)(PARTs + (size_t)t * NSEL + lane * 2) = make_float2(d2[0], d2[1]);
    }
}
__device__ __forceinline__ void peer_v_tokens(const float* __restrict__ W, const int* __restrict__ IDX, const unsigned char* __restrict__ tab, const float* __restrict__ Xin, const float* __restrict__ g2,
                                              float* __restrict__ Xout, int s, int t0, int t1, int lane) {
    const int g = lane >> 3, j = lane & 7;
    const unsigned char* tb = tab + j * 16;
    const bool g4 = (g & 4) != 0, g2b = (g & 2) != 0, g1 = (g & 1) != 0;
    const int col = s * 128 + j * 16 + 2 * g;
    for (int t = t0; t < t1; ++t) {
        int id[16]; float w[16];
        LOAD_IDS16(id, (const int4*)(IDX + (size_t)t * NSEL + g * 16));
        { const float4* wp = (const float4*)(W + (size_t)t * NSEL + g * 16); const float4 a = wp[0], b = wp[1], c = wp[2], d = wp[3];
          w[0] = a.x; w[1] = a.y; w[2] = a.z; w[3] = a.w; w[4] = b.x; w[5] = b.y; w[6] = b.z; w[7] = b.w; w[8] = c.x; w[9] = c.y; w[10] = c.z; w[11] = c.w; w[12] = d.x; w[13] = d.y; w[14] = d.z; w[15] = d.w; }
        uint4 r[16];
#pragma unroll
        for (int i = 0; i < 16; ++i) r[i] = *(const uint4*)(tb + (unsigned)id[i] * 128u);
        f32x2 acc[8];
#pragma unroll
        for (int k = 0; k < 8; ++k) acc[k] = (f32x2){0.f, 0.f};
#pragma unroll
        for (int i = 0; i < 16; ++i) { const f32x2 ww = {w[i], w[i]};
            acc[0] += ww * FP8X2(r[i].x, false); acc[1] += ww * FP8X2(r[i].x, true); acc[2] += ww * FP8X2(r[i].y, false); acc[3] += ww * FP8X2(r[i].y, true);
            acc[4] += ww * FP8X2(r[i].z, false); acc[5] += ww * FP8X2(r[i].z, true); acc[6] += ww * FP8X2(r[i].w, false); acc[7] += ww * FP8X2(r[i].w, true); }
        f32x2 b4[4], c2[2];
#pragma unroll
        for (int i = 0; i < 4; ++i) { const f32x2 keep = g4 ? acc[i + 4] : acc[i], send = g4 ? acc[i] : acc[i + 4]; b4[i] = (f32x2){keep.x + shx(send.x, 32, lane), keep.y + shx(send.y, 32, lane)}; }
#pragma unroll
        for (int i = 0; i < 2; ++i) { const f32x2 keep = g2b ? b4[i + 2] : b4[i], send = g2b ? b4[i] : b4[i + 2]; c2[i] = (f32x2){keep.x + shx(send.x, 16, lane), keep.y + shx(send.y, 16, lane)}; }
        const f32x2 keep = g1 ? c2[1] : c2[0], send = g1 ? c2[0] : c2[1];
        const f32x2 o = {keep.x + shx(send.x, 8, lane), keep.y + shx(send.y, 8, lane)};
        const int b = t / SEQ;
        const float2 xi = *(const float2*)(Xin + (size_t)t * D + col), gg = *(const float2*)(g2 + (size_t)b * 6144 + col);
        *(float2*)(Xout + (size_t)t * D + col) = make_float2(xi.x + gg.x * o.x, xi.y + gg.y * o.y);
    }
}
struct PeerOwn { int first_slice, slice_step, t0, t1; };
__device__ __forceinline__ PeerOwn peer_own(unsigned* bar, unsigned x, unsigned rank, int wid) {
    unsigned nx = 0, px = 0, nloc = 1;
#pragma unroll
    for (unsigned jx = 0; jx < 16; ++jx) { const unsigned cnt = xb_ld(&bar[XB_XCNT(jx)]); if (jx == x) { px = nx; nloc = cnt ? cnt : 1u; } nx += cnt ? 1u : 0u; }
    if (rank >= nloc) rank = nloc - 1;
    const unsigned nw = nloc * (NT / 64), wr = rank * (NT / 64) + wid;
    PeerOwn o; o.first_slice = (int)px; o.slice_step = (int)(nx ? nx : 1u);
    o.t0 = (int)(((unsigned long long)wr * T) / nw); o.t1 = (int)(((unsigned long long)(wr + 1) * T) / nw);
    return o;
}

constexpr int LDS_MISC = pg8::STAGE_BYTES;
constexpr int LDS_BYTES = pg8::STAGE_BYTES + 256;
extern __shared__ __attribute__((aligned(16))) unsigned char smem[];
#ifndef PROBE_ID
#define PROBE_ID 0
#endif
__global__ void __launch_bounds__(NT, 2) mega_fwd(Params p) {
    unsigned char* lds = smem;
    PG8_LAS unsigned char* ldsl = (PG8_LAS unsigned char*)smem;
    volatile LAS unsigned* bst = (volatile LAS unsigned*)(smem + LDS_MISC);
    unsigned char* ws = p.ws;
    if (threadIdx.x == 0) { bst[0] = 0u; bst[1] = 0u; bst[2] = xb_add((unsigned*)(ws + WS_CTL) + XB_RANK(xb_xcc_id()), 1u); }
    __syncthreads();
    const XcdBarrier bar = xcd_barrier_post((unsigned*)(ws + WS_CTL), bst);
#define GRID_SYNC() xcd_barrier(bar)
#define PH_BEGIN(id) for (int _rep = 0; _rep < ((PROBE_ID) == (id) ? 3 : 1); ++_rep) {
#define PH_END() GRID_SYNC(); }
    if (threadIdx.x < 20) ((const float**)(ws + WS_CTL + PTAB_OFF))[threadIdx.x] = threadIdx.x < 19 ? p.in[threadIdx.x] : (const float*)p.out;
#define INP(i) ld_uniform_ptr(ws + WS_CTL + PTAB_OFF, (i))
    unsigned char* U8 = ws + WS_U16; unsigned char* V8 = ws + WS_V16; float* USC = (float*)(ws + WS_USC); float* VSC = (float*)(ws + WS_VSC);
    bf16_t* Wci = (bf16_t*)(ws + WS_WCI); bf16_t* Wco = (bf16_t*)(ws + WS_WCO); bf16_t* Wpi = (bf16_t*)(ws + WS_WPI); bf16_t* Wpg = (bf16_t*)(ws + WS_WPG); bf16_t* Wpo = (bf16_t*)(ws + WS_WPO);
    bf16_t* Wq = (bf16_t*)(ws + WS_WQ); bf16_t* Kbd = (bf16_t*)(ws + WS_KBD);
    float* mod = (float*)(ws + WS_MOD);
    bf16_t* Hh = (bf16_t*)(ws + WS_HH); bf16_t* Bg = (bf16_t*)(ws + WS_BG); bf16_t* Vv = (bf16_t*)(ws + WS_VV); bf16_t* Aa = (bf16_t*)(ws + WS_AA);
    float* S = (float*)(ws + WS_HH);
    float* XA = (float*)(ws + WS_XA); bf16_t* H2 = (bf16_t*)(ws + WS_H2); bf16_t* Qq = (bf16_t*)(ws + WS_QQ);
    int* IDX = (int*)(ws + WS_IDX); float* GATE = (float*)(ws + WS_GATE);
    float* PART = (float*)(ws + WS_HH);
    float* Wg = (float*)(ws + WS_QQ);
    const int G = gridDim.x;
    pg8::StaticOrder so;

    PH_BEGIN(1)
        constexpr int N_UV = 2 * NE / 16;
        constexpr int I_U = 0, I_V = I_U + N_UV, I_KB = I_V + N_UV, I_CI = I_KB + 16, I_CO = I_CI + 48 * 16, I_PI = I_CO + 256, I_PG = I_PI + 256, I_PO = I_PG + 64,
                      I_WQ = I_PO + 256, I_MOD = I_WQ + 2 * 32 * 16, I_END = I_MOD + 192;
        float* cact = (float*)(lds + 32768);
        if ((int)blockIdx.x + ((I_END - I_MOD + G - 1) / G) * 0 >= 0) { const int tid = otid(); for (int i = tid; i < 8 * D; i += NT) { const float v = p.in[1][i]; cact[i] = v / (1.0f + __expf(-v)); } }
        __syncthreads();
        for (int w0 = blockIdx.x; w0 < I_END; w0 += G) {
            const int w = (w0 < 192) ? (I_MOD + w0) : (w0 - 192);
            if (w < I_V) { const int tid = otid(); cvt_rows_fp8(p.in[16], U8, USC, (w - I_U) * 16 + (tid >> 6) * 2, tid & 63); }
            else if (w < I_KB) { const int tid = otid(); cvt_rows_fp8(p.in[17], V8, VSC, (w - I_V) * 16 + (tid >> 6) * 2, tid & 63); }
            else if (w < I_CI) kbd_item(p.in[14], p.in[15], Kbd, w - I_KB);
            else if (w < I_CO) { const int i = w - I_CI; transpose_tile<1>(p.in[6], Wci, D, 3072, i % 48, i / 48, (float*)lds); }
            else if (w < I_PI) { const int i = w - I_CO; transpose_tile<0>(p.in[8], Wco, D, D, i % 16, i / 16, (float*)lds); }
            else if (w < I_PG) { const int i = w - I_PI; transpose_tile<0>(p.in[9], Wpi, D, D, i % 16, i / 16, (float*)lds); }
            else if (w < I_PO) { const int i = w - I_PG, g = i >> 4, j = i & 15; transpose_tile<0>(p.in[10] + (size_t)g * 65536, Wpg + (size_t)g * 65536, 256, 256, j % 4, j / 4, (float*)lds); }
            else if (w < I_WQ) { const int i = w - I_PO; transpose_tile<0>(p.in[12], Wpo, D, D, i % 16, i / 16, (float*)lds); }
            else if (w < I_MOD) { const int i = w - I_WQ, l = i >> 9, j = i & 511; transpose_tile<0>(p.in[13] + (size_t)l * D * 2048, Wq + (size_t)l * 2048 * D, D, 2048, j % 32, j / 32, (float*)lds); }
            else mod_item(cact, p.in[4], p.in[5], mod, w - I_MOD, (float*)lds);
        }
    PH_END()

    const float* xin = INP(0);
    for (int l = 0; l < 2; ++l) {
        const float* ml = mod + (size_t)l * 8 * 6144;
        float* x1 = XA; float* x2 = (float*)INP(19);
        PH_BEGIN(2) { const int tid = otid(); for (int r = blockIdx.x * 8 + (tid >> 6); r < T; r += G * 8) rmsnorm_row<0>(xin, INP(2) + l * D, ml + 0, ml + 1024, Hh, nullptr, r, tid & 63); } PH_END()
        if (l == 0) {
            PH_BEGIN(3) so.init(T, 3072, G, blockIdx.x); pg8::gemm_phase(ldsl, pg8::Gemm{Hh, Wci, D, D, D, 0}, so, EpiConvIn{Bg, Vv}); PH_END()
            PH_BEGIN(4) { const float* cw = INP(7); const size_t i0 = (size_t)blockIdx.x * NT + otid(), st = (size_t)G * NT;
                for (size_t i = i0; i < (size_t)T * D / 8; i += 2 * st) { conv_elem8(Bg, Vv, cw, Aa, i); if (i + st < (size_t)T * D / 8) conv_elem8(Bg, Vv, cw, Aa, i + st); } } PH_END()
            PH_BEGIN(3) so.init(T, D, G, blockIdx.x); pg8::gemm_phase(ldsl, pg8::Gemm{Aa, Wco, D, D, D, 0}, so, EpiResid{xin, x1, ml + 2048}); PH_END()
        } else {
            PH_BEGIN(3) so.init(T, D, G, blockIdx.x); pg8::gemm_phase(ldsl, pg8::Gemm{Hh, Wpi, D, D, D, 0}, so, EpiBf16{Bg, D, 0}); PH_END()
            PH_BEGIN(4) { const int tid = otid(), wv = tid >> 6, lane = tid & 63;
                for (int it = blockIdx.x * 8 + wv; it < (T / 2) * 4; it += G * 8) { const int grp = it & 3, t = (it >> 2) * 2 + (lane >> 5), c8 = grp * 32 + (lane & 31);
                    if (grp == 0) pool_elem8<2>(Bg, Vv, t, c8); else if (grp == 1) pool_elem8<4>(Bg, Vv, t, c8); else if (grp == 2) pool_elem8<8>(Bg, Vv, t, c8); else pool_elem8<16>(Bg, Vv, t, c8); } } PH_END()
            PH_BEGIN(3) so.init(T, D, G, blockIdx.x); pg8::gemm_phase(ldsl, pg8::Gemm{Vv, Wpg, D, 256, 256, 512}, so, EpiScaleBf16{Aa, INP(11), D, 0}); PH_END()
            PH_BEGIN(3) so.init(T, D, G, blockIdx.x); pg8::gemm_phase(ldsl, pg8::Gemm{Aa, Wpo, D, D, D, 0}, so, EpiResid{xin, x1, ml + 2048}); PH_END()
        }
        PH_BEGIN(2) { const int tid = otid(); for (int r = blockIdx.x * 8 + (tid >> 6); r < T; r += G * 8) rmsnorm_row<0>(x1, INP(3) + l * D, ml + 3072, ml + 4096, H2, nullptr, r, tid & 63); } PH_END()
        PH_BEGIN(3) so.init(T, 2048, G, blockIdx.x); pg8::gemm_phase(ldsl, pg8::Gemm{H2, Wq + (size_t)l * 2048 * D, D, D, D, 0}, so, EpiBf16{Qq, 2048, 0}); PH_END()
        PH_BEGIN(5) so.init(T * 8, 256, G, blockIdx.x); pg8::gemm_phase(ldsl, pg8::Gemm{Qq, Kbd + (size_t)l * 65536, 256, 256, 256, 0}, so, EpiF32{S, 256, 0}); PH_END()
        PH_BEGIN(6) for (size_t pi = (size_t)blockIdx.x * NT + otid(); pi < (size_t)T * 8; pi += (size_t)G * NT) topk_pair(S, IDX, GATE, pi); PH_END()
        PH_BEGIN(7) {
            const int tid = otid(), lane = tid & 63;
            const PeerOwn own = peer_own(bar.bar, bar.x, bst[2], tid >> 6);
            for (int sl = own.first_slice; sl < 8; sl += own.slice_step)
                peer_u_tokens(H2, IDX, U8 + ((size_t)l * 8 + sl) * NE * 128, PART + (size_t)sl * T * NSEL, sl, own.t0, own.t1, lane);
        } PH_END()
        PH_BEGIN(8) for (size_t i = (size_t)blockIdx.x * NT + otid(); i < (size_t)T * NSEL / 4; i += (size_t)G * NT) {
            float4 a = ((const float4*)PART)[i];
#pragma unroll
            for (int sl = 1; sl < 8; ++sl) { const float4 q = ((const float4*)(PART + (size_t)sl * T * NSEL))[i]; a.x += q.x; a.y += q.y; a.z += q.z; a.w += q.w; }
            const float4 gt = ((const float4*)GATE)[i]; const int4 id = ((const int4*)IDX)[i];
            const float* us = USC + (size_t)l * NE; const float* vs = VSC + (size_t)l * NE;
            a.x *= us[id.x]; a.y *= us[id.y]; a.z *= us[id.z]; a.w *= us[id.w];
            float4 o;
            o.x = gt.x * vs[id.x] * 0.5f * a.x * (1.0f + erff(a.x * 0.70710678118654752f)); o.y = gt.y * vs[id.y] * 0.5f * a.y * (1.0f + erff(a.y * 0.70710678118654752f));
            o.z = gt.z * vs[id.z] * 0.5f * a.z * (1.0f + erff(a.z * 0.70710678118654752f)); o.w = gt.w * vs[id.w] * 0.5f * a.w * (1.0f + erff(a.w * 0.70710678118654752f));
            ((float4*)Wg)[i] = o;
        } PH_END()
        PH_BEGIN(9) {
            const int tid = otid(), lane = tid & 63;
            const PeerOwn own = peer_own(bar.bar, bar.x, bst[2], tid >> 6);
            for (int sl = own.first_slice; sl < 8; sl += own.slice_step)
                peer_v_tokens(Wg, IDX, V8 + ((size_t)l * 8 + sl) * NE * 128, x1, ml + 5120, x2, sl, own.t0, own.t1, lane);
        } PH_END()
        xin = x2;
    }
    { float* XB = (float*)INP(19); const float* fg = INP(18); const int tid = otid(); for (int r = blockIdx.x * 8 + (tid >> 6); r < T; r += G * 8) rmsnorm_row<1>(XB, fg, nullptr, nullptr, nullptr, XB, r, tid & 63); }
}

extern "C" void kernel_launch(void* const* d_in, const int* in_sizes, int n_in, void* d_out, int out_size, void* d_ws, size_t ws_size, hipStream_t stream) {
    static int grid = 0;
    if (grid == 0) {
        if (n_in != 19 || ws_size < WS_END) { fprintf(stderr, "kernel_launch: expected 19 inputs and >= %zu bytes of workspace (got %d, %zu)\n", (size_t)WS_END, n_in, ws_size); grid = -1; return; }
        int dev = 0, cus = 0, per_cu = 0;
        (void)hipGetDevice(&dev);
        (void)hipDeviceGetAttribute(&cus, hipDeviceAttributeMultiprocessorCount, dev);
        if (hipFuncSetAttribute((const void*)mega_fwd, hipFuncAttributeMaxDynamicSharedMemorySize, LDS_BYTES) != hipSuccess) { fprintf(stderr, "kernel_launch: cannot get %d bytes of dynamic LDS\n", LDS_BYTES); grid = -1; return; }
        (void)hipOccupancyMaxActiveBlocksPerMultiprocessor(&per_cu, (const void*)mega_fwd, NT, LDS_BYTES);
        if (per_cu < 1) { fprintf(stderr, "kernel_launch: occupancy query says %d blocks per CU\n", per_cu); grid = -1; return; }
        grid = cus;
        fprintf(stderr, "kernel_launch: %d CUs, occupancy query %d block(s) per CU, grid %d\n", cus, per_cu, grid);
    }
    if (grid < 0) return;
    (void)hipMemsetAsync((unsigned char*)d_ws + WS_CTL, 0, CTL_BYTES, stream);
    Params p{};
    for (int i = 0; i < 19; ++i) p.in[i] = (const float*)d_in[i];
    p.out = (float*)d_out; p.ws = (unsigned char*)d_ws;
    void* args[] = {&p};
    hipError_t e = hipLaunchCooperativeKernel((const void*)mega_fwd, dim3(grid), dim3(NT), args, LDS_BYTES, stream);
    if (e != hipSuccess) fprintf(stderr, "kernel_launch: cooperative launch failed: %s (grid %d)\n", hipGetErrorString(e), grid);
}
```

```cpp
#include <hip/hip_runtime.h>
#include <cstdio>
#include <cstdint>
#include <utility>

typedef unsigned short bf16_t;
typedef short bf16x8 __attribute__((ext_vector_type(8)));
typedef float f32x4 __attribute__((ext_vector_type(4)));
typedef float f32x2 __attribute__((ext_vector_type(2)));
typedef unsigned u32x2 __attribute__((ext_vector_type(2)));
constexpr int NT = 512;

constexpr int D = 1024, NB = 8, SEQ = 2048, T = NB * SEQ;
constexpr int NE = 16384, NH = 8, TOPK = 16, NSEL = NH * TOPK;
constexpr float EPS = 1e-6f;

__device__ __forceinline__ unsigned f2bf(float f) { unsigned u = __builtin_bit_cast(unsigned, f); return (u + 0x7fffu + ((u >> 16) & 1u)) >> 16; }
__device__ __forceinline__ unsigned pk2(float lo, float hi) { return f2bf(lo) | (f2bf(hi) << 16); }
__device__ __forceinline__ float bf_lo(unsigned u) { return __builtin_bit_cast(float, u << 16); }
__device__ __forceinline__ float bf_hi(unsigned u) { return __builtin_bit_cast(float, u & 0xffff0000u); }
__device__ __forceinline__ int otid() { int t = threadIdx.x; asm volatile("" : "+v"(t)); return t; }
__device__ __forceinline__ const float* ld_uniform_ptr(const unsigned char* tab, int i) {
    const unsigned long long v = ((const unsigned long long*)tab)[i];
    const unsigned lo = __builtin_amdgcn_readfirstlane((unsigned)v), hi = __builtin_amdgcn_readfirstlane((unsigned)(v >> 32));
    return (const float*)(((unsigned long long)hi << 32) | lo);
}
__device__ __forceinline__ float shx(float v, int m, int lane) { return __builtin_bit_cast(float, __builtin_amdgcn_ds_bpermute((lane ^ m) << 2, __builtin_bit_cast(int, v))); }
__device__ __forceinline__ float wave_sum(float v, int lane) {
#pragma unroll
    for (int o = 32; o > 0; o >>= 1) v += shx(v, o, lane);
    return v;
}

#define XB_TMO      128
#define XB_XCNT(j)  (256  + 64 * (j))
#define XB_XSUB(j)  (1280 + 64 * (j))
#define XB_XGEN(j)  (2304 + 64 * (j))
#define XB_TOP      3328
#define XB_TOPGEN   3392
#define XCD_BAR_WORDS 3456
#define XB_RANK(j)  (3584 + 64 * (j))
#define CTL_BYTES 32768
#define PTAB_OFF 24576
#define XB_SPIN_CAP (1u << 18)
#define LAS __attribute__((address_space(3)))
__device__ __forceinline__ unsigned xb_ld(unsigned* p)              { return __hip_atomic_load(p, __ATOMIC_RELAXED, __HIP_MEMORY_SCOPE_AGENT); }
__device__ __forceinline__ unsigned xb_add(unsigned* p, unsigned v) { return __hip_atomic_fetch_add(p, v, __ATOMIC_RELAXED, __HIP_MEMORY_SCOPE_AGENT); }
__device__ __forceinline__ unsigned xb_xcc_id() { return (unsigned)__builtin_amdgcn_s_getreg((3 << 11) | 20) & 0xFu; }
#define XB_SPIN(cond, bar) do { unsigned _sp = 0; while (cond) { __builtin_amdgcn_s_sleep(1); \
    if ((++_sp & 255u) == 0u) { if (xb_ld(&(bar)[XB_TMO])) break; if (_sp > XB_SPIN_CAP) { atomicAdd(&(bar)[XB_TMO], 1u); break; } } } } while (0)
struct XcdBarrier { unsigned* bar; unsigned x; volatile LAS unsigned* st; };
__device__ __forceinline__ XcdBarrier xcd_barrier_post(unsigned* bar, volatile LAS unsigned* st) {
    XcdBarrier b; b.bar = bar; b.x = xb_xcc_id(); b.st = st;
    if (threadIdx.x == 0) (void)xb_add(&bar[XB_XCNT(b.x)], 1u);
    return b;
}
__device__ __forceinline__ void xcd_barrier_complete(unsigned* bar, unsigned x, unsigned& nloc, unsigned& nx) {
    const unsigned G = gridDim.x * gridDim.y * gridDim.z;
    unsigned sum, cnt, mine, sp = 0u;
    for (;;) {
        sum = 0u; cnt = 0u; mine = 0u;
#pragma unroll
        for (unsigned j = 0; j < 16; ++j) { const unsigned c = xb_ld(&bar[XB_XCNT(j)]); sum += c; cnt += (c > 0u) ? 1u : 0u; mine = (j == x) ? c : mine; }
        if (sum == G) break;
        __builtin_amdgcn_s_sleep(1);
        if ((++sp & 255u) == 0u) { if (xb_ld(&bar[XB_TMO])) break; if (sp > XB_SPIN_CAP) { atomicAdd(&bar[XB_TMO], 1u); break; } }
    }
    nloc = mine > 0u ? mine : 1u; nx = cnt > 0u ? cnt : 1u;
}
__device__ __forceinline__ void xcd_barrier(const XcdBarrier& b) {
    asm volatile("s_waitcnt vmcnt(0)" ::: "memory");
    __syncthreads();
    if (threadIdx.x == 0) {
        unsigned* bar = b.bar;
        __builtin_amdgcn_s_waitcnt(0);
        unsigned nloc = b.st[0], nx = b.st[1];
        if (nloc == 0u) { xcd_barrier_complete(bar, b.x, nloc, nx); b.st[0] = nloc; b.st[1] = nx; }
        const unsigned old = xb_add(&bar[XB_XSUB(b.x)], 1u);
        const unsigned gen = old / nloc;
        if (old + 1u == (gen + 1u) * nloc) {
            __builtin_amdgcn_fence(__ATOMIC_RELEASE, "agent");
            asm volatile("s_waitcnt vmcnt(0)" ::: "memory");
            const unsigned og = xb_add(&bar[XB_TOP], 1u);
            const unsigned tg = og / nx;
            if (og + 1u == (tg + 1u) * nx) xb_add(&bar[XB_TOPGEN], 1u);
            else XB_SPIN(xb_ld(&bar[XB_TOPGEN]) == tg, bar);
            __builtin_amdgcn_fence(__ATOMIC_ACQUIRE, "agent");
            xb_add(&bar[XB_XGEN(b.x)], 1u);
            asm volatile("s_waitcnt vmcnt(0)" ::: "memory");
        } else {
            XB_SPIN(xb_ld(&bar[XB_XGEN(b.x)]) == gen, bar);
            __builtin_amdgcn_fence(__ATOMIC_ACQUIRE, "agent");
            asm volatile("s_waitcnt vmcnt(0)" ::: "memory");
        }
    }
    __syncthreads();
}

namespace pg8 {
#define PG8_LAS __attribute__((address_space(3)))
constexpr int BM = 256, BK = 64, HALF = 128, HTB = HALF * BK * 2  , STAGE_BYTES = 8 * HTB, NXCD = 8, WGM = 8;
__host__ __device__ __forceinline__ int lds_byte(int r, int c) { const int st = (r >> 4) * 2 + (c >> 5), rr = r & 15, cc = c & 31, ob = rr * 64 + cc * 2; return st * 1024 + (ob ^ (((ob >> 9) & 1) << 5)); }
__host__ __device__ __forceinline__ void stage_rc(int b, int& R, int& C) { const int st = b / 1024, sb = b % 1024, swz = sb ^ (((sb >> 9) & 1) << 5); R = (st >> 1) * 16 + swz / 64; C = (st & 1) * 32 + (swz % 64) / 2; }
__host__ __device__ __forceinline__ int perm32(int rho) { const int n = rho >> 4, i = rho & 15; return 8 * (i >> 2) + 4 * n + (i & 3); }

struct Unit { int pm, pn; };
struct Gemm { const bf16_t* A; const bf16_t* Bt; int lda, ldb, K, a_colstep; };
struct StaticOrder {
    int nM, nN, nwg, G, c;
    __host__ __device__ void init(int M, int N, int G_, int c_) { nM = M / BM; nN = N / BM; nwg = nM * nN; G = G_; c = c_; }
    __host__ __device__ bool next(int i, Unit& u) const {
        const long L = (long)i * G + c; if (L >= nwg) return false;
        int wgid = (int)L; { const int q = nwg / NXCD, r = nwg % NXCD, xcd = wgid % NXCD, off = wgid / NXCD; wgid = (xcd < r ? xcd * (q + 1) : r * (q + 1) + (xcd - r) * q) + off; }
        const int nig = WGM * nN, gid = wgid / nig, fm = gid * WGM, gsz = (nM - fm) < WGM ? (nM - fm) : WGM;
        u.pm = fm + ((wgid % nig) % gsz); u.pn = (wgid % nig) / gsz; return true;
    }
    __device__ __forceinline__ void a_ready(const Unit&) const {}
    __device__ __forceinline__ void done(const Unit&) const {}
};
template <class Epi, class Sched>
__device__ __forceinline__ void gemm_phase(PG8_LAS unsigned char* lds, const Gemm g, const Sched& S, const Epi& E) {
    const int tid = otid(), wid = __builtin_amdgcn_readfirstlane(tid >> 6), lane = tid & 63, wr = wid >> 2, wc = wid & 3, fr = lane & 15, fq = lane >> 4;
    const int K = g.K, nt = K / BK;
    unsigned voffA[2], voffB[2];
#pragma unroll
    for (int i = 0; i < 2; ++i) { int R, C; stage_rc(tid * 16 + i * 8192, R, C); const int Rb = Epi::PERM ? ((R & ~31) + perm32(R & 31)) : R;
        voffA[i] = (unsigned)(R * g.lda + C) * 2u; voffB[i] = (unsigned)(Rb * g.ldb + C) * 2u; }
    const size_t kstep = (size_t)(BK * 2);
    const size_t hstepA = (size_t)HALF * g.lda * 2, hstepB = (size_t)HALF * g.ldb * 2;
    const size_t tstepA = 2 * hstepA, tstepB = 2 * hstepB;
    const size_t acs = (size_t)g.a_colstep;
    const unsigned ldsw = (unsigned)wid * 1024u;
    const int aoff = lds_byte(wr * 64 + fr, fq * 8), boff = lds_byte(wc * 32 + fr, fq * 8);
#define PG8_SA(b, h) (((b) * 2 + (h)) * HTB)
#define PG8_SB(b, h) ((4 + (b) * 2 + (h)) * HTB)
#define PG8_STAGE(bufoff, gbase, voff) do { _Pragma("unroll") for (int _i = 0; _i < 2; ++_i) \
        __builtin_amdgcn_global_load_lds((const unsigned*)((const char*)(gbase) + (voff)[_i]), (PG8_LAS unsigned*)(lds + (bufoff) + ldsw + _i * 8192), 16, 0, 0); } while (0)
#define PG8_LDA(dst, b, h) do { _Pragma("unroll") for (int m = 0; m < 4; ++m) _Pragma("unroll") for (int k = 0; k < 2; ++k) dst[m][k] = *(const PG8_LAS bf16x8*)(lds + PG8_SA(b, h) + aoff + m * 2048 + k * 1024); } while (0)
#define PG8_LDB(dst, b, h) do { _Pragma("unroll") for (int n = 0; n < 2; ++n) _Pragma("unroll") for (int k = 0; k < 2; ++k) dst[n][k] = *(const PG8_LAS bf16x8*)(lds + PG8_SB(b, h) + boff + n * 2048 + k * 1024); } while (0)
#define PG8_MMA(ai, bj, At, Bt) do { __builtin_amdgcn_s_setprio(1); _Pragma("unroll") for (int m = 0; m < 4; ++m) _Pragma("unroll") for (int n = 0; n < 2; ++n) _Pragma("unroll") for (int k = 0; k < 2; ++k) \
        acc[ai][bj][m][n] = __builtin_amdgcn_mfma_f32_16x16x32_bf16(Bt[n][k], At[m][k], acc[ai][bj][m][n], 0, 0, 0); __builtin_amdgcn_s_setprio(0); } while (0)
#define PG8_WAIT_V(n) asm volatile("s_waitcnt vmcnt(" #n ")" ::: "memory")
#define PG8_WAIT_L(n) asm volatile("s_waitcnt lgkmcnt(" #n ")" ::: "memory")
#define PG8_BAR __builtin_amdgcn_s_barrier()
#define PG8_SCHED __builtin_amdgcn_sched_barrier(0)
    Unit cur, nxt; int ui = 0;
    if (!S.next(0, cur)) return;
    f32x4 acc[2][2][4][2];
#pragma unroll
    for (int a = 0; a < 2; ++a)
#pragma unroll
        for (int b = 0; b < 2; ++b)
#pragma unroll
            for (int m = 0; m < 4; ++m)
#pragma unroll
                for (int n = 0; n < 2; ++n) acc[a][b][m][n] = (f32x4){0.f, 0.f, 0.f, 0.f};
    bf16x8 At[4][2], B0[2][2], B1[2][2];
    const char* cA = (const char*)g.A + (size_t)cur.pm * tstepA + (size_t)cur.pn * acs; const char* cB = (const char*)g.Bt + (size_t)cur.pn * tstepB;
    S.a_ready(cur);
    PG8_STAGE(PG8_SB(0, 0), cB, voffB); PG8_STAGE(PG8_SA(0, 0), cA, voffA); PG8_STAGE(PG8_SB(0, 1), cB + hstepB, voffB); PG8_STAGE(PG8_SA(0, 1), cA + hstepA, voffA);
    if (wr == 1) PG8_BAR;
    PG8_WAIT_V(4); PG8_BAR;
    PG8_STAGE(PG8_SB(1, 0), cB + kstep, voffB); PG8_STAGE(PG8_SA(1, 0), cA + kstep, voffA); PG8_STAGE(PG8_SB(1, 1), cB + hstepB + kstep, voffB);
    PG8_WAIT_V(6); PG8_BAR;
    for (;;) {
        const bool has_next = S.next(ui + 1, nxt);
        const char* nA = has_next ? (const char*)g.A + (size_t)nxt.pm * tstepA + (size_t)nxt.pn * acs : cA; const char* nB = has_next ? (const char*)g.Bt + (size_t)nxt.pn * tstepB : cB;
        for (int t = 0; t < nt; t += 2) {
            const bool last = (t == nt - 2);
            const char* a1 = cA + (size_t)(t + 1) * kstep;
            const char* a2 = last ? nA : cA + (size_t)(t + 2) * kstep; const char* b2 = last ? nB : cB + (size_t)(t + 2) * kstep;
            const char* a3 = a2 + kstep; const char* b3 = b2 + kstep;
            if (last && has_next) S.a_ready(nxt);
            PG8_LDB(B0, 0, 0); PG8_SCHED; PG8_LDA(At, 0, 0); PG8_STAGE(PG8_SA(1, 1), a1 + hstepA, voffA);
            PG8_WAIT_L(8); PG8_BAR; PG8_WAIT_L(0); PG8_MMA(0, 0, At, B0); PG8_BAR; PG8_SCHED;
            PG8_LDB(B1, 0, 1); PG8_STAGE(PG8_SB(0, 0), b2, voffB);
            PG8_BAR; PG8_WAIT_L(0); PG8_MMA(0, 1, At, B1); PG8_BAR;
            PG8_LDA(At, 0, 1); PG8_STAGE(PG8_SA(0, 0), a2, voffA);
            PG8_BAR; PG8_WAIT_L(0); PG8_MMA(1, 0, At, B0); PG8_BAR; PG8_SCHED;
            PG8_STAGE(PG8_SB(0, 1), b2 + hstepB, voffB);
            PG8_WAIT_V(6); PG8_BAR; PG8_MMA(1, 1, At, B1); PG8_BAR;
            PG8_LDB(B0, 1, 0); PG8_SCHED; PG8_LDA(At, 1, 0); PG8_STAGE(PG8_SA(0, 1), a2 + hstepA, voffA);
            PG8_WAIT_L(8); PG8_BAR; PG8_WAIT_L(0); PG8_MMA(0, 0, At, B0); PG8_BAR; PG8_SCHED;
            PG8_LDB(B1, 1, 1); PG8_STAGE(PG8_SB(1, 0), b3, voffB);
            PG8_BAR; PG8_WAIT_L(0); PG8_MMA(0, 1, At, B1); PG8_BAR;
            PG8_LDA(At, 1, 1); PG8_STAGE(PG8_SA(1, 0), a3, voffA);
            PG8_BAR; PG8_WAIT_L(0); PG8_MMA(1, 0, At, B0); PG8_BAR; PG8_SCHED;
            PG8_STAGE(PG8_SB(1, 1), b3 + hstepB, voffB);
            PG8_WAIT_V(6); PG8_BAR; PG8_MMA(1, 1, At, B1); PG8_BAR;
        }
            if constexpr (!Epi::AFTER_DRAIN) { int te = tid; asm volatile("" : "+v"(te));
            const int we = __builtin_amdgcn_readfirstlane(te >> 6), le = te & 63; E(acc, cur, we >> 2, we & 3, le & 15, le >> 4); S.done(cur); }
            if (!has_next) break;
#pragma unroll
        for (int a = 0; a < 2; ++a)
#pragma unroll
            for (int b = 0; b < 2; ++b)
#pragma unroll
                for (int m = 0; m < 4; ++m)
#pragma unroll
                    for (int n = 0; n < 2; ++n) acc[a][b][m][n] = (f32x4){0.f, 0.f, 0.f, 0.f};
        cur = nxt; cA = nA; cB = nB; ++ui;
    }
    PG8_WAIT_V(0);
    if (wr == 0) PG8_BAR;
    PG8_BAR;
    if constexpr (Epi::AFTER_DRAIN) { E.fused(acc, cur, wr, wc, fr, fq, lds, wid, lane); S.done(cur); }
#undef PG8_SA
#undef PG8_SB
#undef PG8_STAGE
#undef PG8_LDA
#undef PG8_LDB
#undef PG8_MMA
#undef PG8_WAIT_V
#undef PG8_WAIT_L
#undef PG8_BAR
#undef PG8_SCHED
}
}

using pg8::Unit;
struct EpiBf16 {
    static constexpr bool PERM = false, AFTER_DRAIN = false;
    bf16_t* O; int ldc; int pad;
    __device__ __forceinline__ void operator()(const f32x4 (&acc)[2][2][4][2], const Unit& u, int wr, int wc, int fr, int fq) const {
        const int row0 = u.pm * 256 + wr * 64 + fr, col0 = u.pn * 256 + wc * 32 + 4 * fq;
#pragma unroll
        for (int ai = 0; ai < 2; ++ai)
#pragma unroll
            for (int m = 0; m < 4; ++m) { bf16_t* rowp = O + (size_t)(row0 + ai * 128 + m * 16) * ldc + col0;
#pragma unroll
                for (int bj = 0; bj < 2; ++bj)
#pragma unroll
                    for (int n = 0; n < 2; ++n) { const f32x4 v = acc[ai][bj][m][n]; u32x2 o; o.x = pk2(v[0], v[1]); o.y = pk2(v[2], v[3]); *(u32x2*)(rowp + bj * 128 + n * 16) = o; } }
    }
};
struct EpiF32 {
    static constexpr bool PERM = false, AFTER_DRAIN = false;
    float* O; int ldc; int pad;
    __device__ __forceinline__ void operator()(const f32x4 (&acc)[2][2][4][2], const Unit& u, int wr, int wc, int fr, int fq) const {
        const int row0 = u.pm * 256 + wr * 64 + fr, col0 = u.pn * 256 + wc * 32 + 4 * fq;
#pragma unroll
        for (int ai = 0; ai < 2; ++ai)
#pragma unroll
            for (int m = 0; m < 4; ++m) { float* rowp = O + (size_t)(row0 + ai * 128 + m * 16) * ldc + col0;
#pragma unroll
                for (int bj = 0; bj < 2; ++bj)
#pragma unroll
                    for (int n = 0; n < 2; ++n) *(f32x4*)(rowp + bj * 128 + n * 16) = acc[ai][bj][m][n]; }
    }
};
struct EpiScaleBf16 {
    static constexpr bool PERM = false, AFTER_DRAIN = false;
    bf16_t* O; const float* scale; int ldc; int pad;
    __device__ __forceinline__ void operator()(const f32x4 (&acc)[2][2][4][2], const Unit& u, int wr, int wc, int fr, int fq) const {
        const int row0 = u.pm * 256 + wr * 64 + fr, col0 = u.pn * 256 + wc * 32 + 4 * fq;
        f32x4 sv[2][2];
#pragma unroll
        for (int bj = 0; bj < 2; ++bj)
#pragma unroll
            for (int n = 0; n < 2; ++n) sv[bj][n] = *(const f32x4*)(scale + col0 + bj * 128 + n * 16);
#pragma unroll
        for (int ai = 0; ai < 2; ++ai)
#pragma unroll
            for (int m = 0; m < 4; ++m) { bf16_t* rowp = O + (size_t)(row0 + ai * 128 + m * 16) * ldc + col0;
#pragma unroll
                for (int bj = 0; bj < 2; ++bj)
#pragma unroll
                    for (int n = 0; n < 2; ++n) { const f32x4 v = acc[ai][bj][m][n] * sv[bj][n]; u32x2 o; o.x = pk2(v[0], v[1]); o.y = pk2(v[2], v[3]); *(u32x2*)(rowp + bj * 128 + n * 16) = o; } }
    }
};
struct EpiResid {
    static constexpr bool PERM = false, AFTER_DRAIN = false;
    const float* Xin; float* Xout; const float* gate;
    __device__ __forceinline__ void operator()(const f32x4 (&acc)[2][2][4][2], const Unit& u, int wr, int wc, int fr, int fq) const {
        const int row0 = u.pm * 256 + wr * 64 + fr, col0 = u.pn * 256 + wc * 32 + 4 * fq, b = (u.pm * 256) / SEQ;
        f32x4 gv[2][2];
#pragma unroll
        for (int bj = 0; bj < 2; ++bj)
#pragma unroll
            for (int n = 0; n < 2; ++n) gv[bj][n] = *(const f32x4*)(gate + (size_t)b * 6144 + col0 + bj * 128 + n * 16);
#pragma unroll
        for (int ai = 0; ai < 2; ++ai)
#pragma unroll
            for (int m = 0; m < 4; ++m) { const size_t ro = (size_t)(row0 + ai * 128 + m * 16) * D + col0;
#pragma unroll
                for (int bj = 0; bj < 2; ++bj)
#pragma unroll
                    for (int n = 0; n < 2; ++n) { const f32x4 xi = *(const f32x4*)(Xin + ro + bj * 128 + n * 16); *(f32x4*)(Xout + ro + bj * 128 + n * 16) = xi + gv[bj][n] * acc[ai][bj][m][n]; } }
    }
};
struct EpiConvIn {
    static constexpr bool PERM = false, AFTER_DRAIN = false;
    bf16_t* Bg; bf16_t* Vv;
    __device__ __forceinline__ void operator()(const f32x4 (&acc)[2][2][4][2], const Unit& u, int wr, int wc, int fr, int fq) const {
        const int row0 = u.pm * 256 + wr * 64 + fr, colt = u.pn * 256;
        if (colt < 1024) {
            const int col0 = colt + wc * 32 + 4 * fq;
#pragma unroll
            for (int ai = 0; ai < 2; ++ai)
#pragma unroll
                for (int m = 0; m < 4; ++m) { bf16_t* rowp = Bg + (size_t)(row0 + ai * 128 + m * 16) * D + col0;
#pragma unroll
                    for (int bj = 0; bj < 2; ++bj)
#pragma unroll
                        for (int n = 0; n < 2; ++n) { const f32x4 v = acc[ai][bj][m][n]; u32x2 o; o.x = pk2(v[0], v[1]); o.y = pk2(v[2], v[3]); *(u32x2*)(rowp + bj * 128 + n * 16) = o; } }
        } else {
            const int g0 = (colt - 1024) / 32 + wc;
#pragma unroll
            for (int ai = 0; ai < 2; ++ai)
#pragma unroll
                for (int m = 0; m < 4; ++m) { bf16_t* rowp = Vv + (size_t)(row0 + ai * 128 + m * 16) * D + 4 * fq;
#pragma unroll
                    for (int bj = 0; bj < 2; ++bj) { const f32x4 v = acc[ai][bj][m][0] * acc[ai][bj][m][1]; u32x2 o; o.x = pk2(v[0], v[1]); o.y = pk2(v[2], v[3]);
                        *(u32x2*)(rowp + (g0 + 4 * bj) * 16) = o; } }
        }
    }
};

constexpr size_t al256(size_t x) { return (x + 255) & ~(size_t)255; }
constexpr size_t WS_CTL  = 0;
constexpr size_t WS_U16  = al256(WS_CTL + CTL_BYTES);
constexpr size_t WS_V16  = WS_U16 + (size_t)2 * NE * D;
constexpr size_t WS_USC  = WS_V16 + (size_t)2 * NE * D;
constexpr size_t WS_VSC  = WS_USC + (size_t)2 * NE * 4;
constexpr size_t WS_WCI  = WS_VSC + (size_t)2 * NE * 4;
constexpr size_t WS_WCO  = WS_WCI + (size_t)3072 * D * 2;
constexpr size_t WS_WPI  = WS_WCO + (size_t)D * D * 2;
constexpr size_t WS_WPG  = WS_WPI + (size_t)D * D * 2;
constexpr size_t WS_WPO  = WS_WPG + (size_t)4 * 256 * 256 * 2;
constexpr size_t WS_WQ   = WS_WPO + (size_t)D * D * 2;
constexpr size_t WS_KBD  = WS_WQ + (size_t)2 * 2048 * D * 2;
constexpr size_t WS_MOD  = WS_KBD + (size_t)2 * 2 * 128 * 128 * 2;
constexpr size_t WS_HH   = al256(WS_MOD + (size_t)2 * 8 * 6144 * 4);
constexpr size_t WS_BG   = WS_HH + (size_t)T * D * 2;
constexpr size_t WS_VV   = WS_BG + (size_t)T * D * 2;
constexpr size_t WS_AA   = WS_VV + (size_t)T * D * 2;
constexpr size_t WS_XA   = WS_AA + (size_t)T * D * 2;
constexpr size_t WS_H2   = WS_XA + (size_t)T * D * 4;
constexpr size_t WS_QQ   = WS_H2 + (size_t)T * D * 2;
constexpr size_t WS_IDX  = WS_QQ + (size_t)T * 2048 * 2;
constexpr size_t WS_GATE = WS_IDX + (size_t)T * NSEL * 4;
constexpr size_t WS_END  = WS_GATE + (size_t)T * NSEL * 4;

struct Params { const float* in[19]; float* out; unsigned char* ws; };

template <int MODE>
__device__ __forceinline__ void transpose_tile(const float* __restrict__ W, bf16_t* __restrict__ Wt, int K, int N, int tn, int tk, float* tile  ) {
    const int tid = otid(), n0 = tn * 64, k0 = tk * 64, tx = tid & 63, ty = tid >> 6;
#pragma unroll
    for (int i = 0; i < 8; ++i) tile[(ty + 8 * i) * 65 + tx] = W[(size_t)(k0 + ty + 8 * i) * N + n0 + tx];
    __syncthreads();
#pragma unroll
    for (int i = 0; i < 8; ++i) {
        int n = n0 + ty + 8 * i, p = n;
        if (MODE == 1 && n >= 1024) { const int j = (n - 1024) & 1023, isu = (n >= 2048); p = 1024 + (j >> 4) * 32 + isu * 16 + (j & 15); }
        Wt[(size_t)p * K + k0 + tx] = (bf16_t)f2bf(tile[tx * 65 + ty + 8 * i]);
    }
    __syncthreads();
}
__device__ __forceinline__ void cvt_rows_fp8(const float* __restrict__ src, unsigned char* __restrict__ dst, float* __restrict__ isc, int R0, int lane) {
    float4 v[2][4];
#pragma unroll
    for (int q = 0; q < 2; ++q)
#pragma unroll
        for (int i = 0; i < 4; ++i) v[q][i] = ((const float4*)(src + (size_t)(R0 + q) * D + lane * 16))[i];
#pragma unroll
    for (int q = 0; q < 2; ++q) {
        float m = 0.f;
#pragma unroll
        for (int i = 0; i < 4; ++i) m = fmaxf(m, fmaxf(fmaxf(fabsf(v[q][i].x), fabsf(v[q][i].y)), fmaxf(fabsf(v[q][i].z), fabsf(v[q][i].w))));
#pragma unroll
        for (int o = 32; o > 0; o >>= 1) m = fmaxf(m, shx(m, o, lane));
        const float ratio = m > 1e-30f ? 224.0f / m : 1.0f;
        const float sc = __builtin_bit_cast(float, __builtin_bit_cast(unsigned, ratio) & 0x7f800000u);
        int w[4];
#pragma unroll
        for (int i = 0; i < 4; ++i) { int t = 0; t = __builtin_amdgcn_cvt_pk_fp8_f32(v[q][i].x * sc, v[q][i].y * sc, t, false); t = __builtin_amdgcn_cvt_pk_fp8_f32(v[q][i].z * sc, v[q][i].w * sc, t, true); w[i] = t; }
        const int R = R0 + q, l = R >> 14, e = R & (NE - 1), sl = lane >> 3;
        *(int4*)(dst + (((size_t)(l * 8 + sl) * NE + e) << 7) + (lane & 7) * 16) = make_int4(w[0], w[1], w[2], w[3]);
        if (lane == 0) isc[R] = 1.0f / sc;
    }
}
__device__ __forceinline__ void k12_item(const float* __restrict__ k1, const float* __restrict__ k2, bf16_t* __restrict__ K12, int item) {
    const int tid = otid(), l = item >> 1, half = item & 1;
    const float* src = (half ? k2 : k1) + (size_t)l * 16384;
#pragma unroll
    for (int i = 0; i < 8; ++i) { const int e4 = i * NT + tid; const float4 v = ((const float4*)src)[e4]; u32x2 o; o.x = pk2(v.x, v.y); o.y = pk2(v.z, v.w); ((u32x2*)(K12 + (size_t)item * 16384))[e4] = o; }
}
__device__ __forceinline__ void mod_item(const float* __restrict__ cact, const float* __restrict__ w_mod, const float* __restrict__ b_mod, float* __restrict__ mod, int item, float* red  ) {
    const int tid = otid(), l = item / 96, n0 = (item % 96) * 64, col = tid & 63, kg = tid >> 6;
    float acc[8] = {0, 0, 0, 0, 0, 0, 0, 0};
    const float* w = w_mod + (size_t)l * D * 6144 + (size_t)(kg * 128) * 6144 + n0 + col;
#pragma unroll 8
    for (int k = 0; k < 128; ++k) { const float wv = w[(size_t)k * 6144];
#pragma unroll
        for (int b = 0; b < 8; ++b) acc[b] += cact[b * D + kg * 128 + k] * wv; }
#pragma unroll
    for (int b = 0; b < 8; ++b) red[(kg * 8 + b) * 64 + col] = acc[b];
    __syncthreads();
    { const int b = tid >> 6, cc = tid & 63; float s = b_mod[l * 6144 + n0 + cc];
#pragma unroll
      for (int q = 0; q < 8; ++q) s += red[(q * 8 + b) * 64 + cc];
      mod[((size_t)l * 8 + b) * 6144 + n0 + cc] = s; }
    __syncthreads();
}

template <int MODE>
__device__ __forceinline__ void rmsnorm_row(const float* x, const float* __restrict__ g, const float* __restrict__ sh, const float* __restrict__ sc, bf16_t* ob, float* of, int row, int lane) {
    const int b = row / SEQ;
    const float4* xr = (const float4*)(x + (size_t)row * D);
    float4 v[4]; float ss = 0.f;
#pragma unroll
    for (int i = 0; i < 4; ++i) { v[i] = xr[lane + 64 * i]; ss += v[i].x * v[i].x + v[i].y * v[i].y + v[i].z * v[i].z + v[i].w * v[i].w; }
    ss = wave_sum(ss, lane);
    const float r = rsqrtf(ss * (1.0f / D) + EPS);
#pragma unroll
    for (int i = 0; i < 4; ++i) {
        const int c4 = lane + 64 * i; const float4 gg = ((const float4*)g)[c4];
        float4 y; y.x = v[i].x * r * gg.x; y.y = v[i].y * r * gg.y; y.z = v[i].z * r * gg.z; y.w = v[i].w * r * gg.w;
        if (MODE == 0) {
            const float4 s1 = ((const float4*)(sc + (size_t)b * 6144))[c4], s0 = ((const float4*)(sh + (size_t)b * 6144))[c4];
            y.x = y.x * (1.f + s1.x) + s0.x; y.y = y.y * (1.f + s1.y) + s0.y; y.z = y.z * (1.f + s1.z) + s0.z; y.w = y.w * (1.f + s1.w) + s0.w;
            uint2 o; o.x = pk2(y.x, y.y); o.y = pk2(y.z, y.w);
            ((uint2*)(ob + (size_t)row * D))[c4] = o;
        } else ((float4*)(of + (size_t)row * D))[c4] = y;
    }
}
__device__ __forceinline__ int ord_key(float f) { const int b = __builtin_bit_cast(int, f); return b >= 0 ? b : (b ^ 0x7fffffff); }
__device__ __forceinline__ float key_val(int k) { const int b = k >= 0 ? k : (k ^ 0x7fffffff); return __builtin_bit_cast(float, b); }
__device__ __forceinline__ void ce(int& hi, int& lo) { const int a = hi, b = lo; hi = a > b ? a : b; lo = a > b ? b : a; }
__device__ __forceinline__ void sort16_desc(int (&v)[16]) {
#pragma unroll
    for (int ks = 1; ks <= 4; ++ks)
#pragma unroll
        for (int js = ks - 1; js >= 0; --js)
#pragma unroll
            for (int i = 0; i < 16; ++i) { const int k = 1 << ks, j = 1 << js, l = i ^ j; if (l > i) { if ((i & k) == 0) ce(v[i], v[l]); else ce(v[l], v[i]); } }
}
__device__ __forceinline__ void merge16_desc(int (&a)[16], const int (&b)[16]) {
#pragma unroll
    for (int i = 0; i < 16; ++i) a[i] = a[i] > b[15 - i] ? a[i] : b[15 - i];
#pragma unroll
    for (int js = 3; js >= 0; --js)
#pragma unroll
        for (int i = 0; i < 16; ++i) { const int j = 1 << js, l = i ^ j; if (l > i) ce(a[i], a[l]); }
}
__host__ __device__ constexpr int cand_ij(int c) { int n = 0; for (int i = 0; i < 16; ++i) for (int j = 0; j < 16; ++j) if ((i + 1) * (j + 1) <= 16) { if (n == c) return i * 16 + j; ++n; } return -1; }
constexpr int NCAND = 50;
static_assert(cand_ij(NCAND - 1) >= 0 && cand_ij(NCAND) < 0, "candidate count");
template <int C> __device__ __forceinline__ void cand_step(const float (&v1)[16], const float (&v2)[16], int (&cur)[16], int (&run)[16]) {
    constexpr int ij = cand_ij(C), i = ij >> 4, j = ij & 15;
    cur[C & 15] = (ord_key(v1[i] + v2[j]) & ~255) | ij;
    if constexpr ((C & 15) == 15 || C == NCAND - 1) {
        if constexpr (C == NCAND - 1) {
#pragma unroll
            for (int q = (C & 15) + 1; q < 16; ++q) cur[q] = (int)0x80000000;
        }
        sort16_desc(cur);
        if constexpr (C == 15) {
#pragma unroll
            for (int q = 0; q < 16; ++q) run[q] = cur[q];
        } else merge16_desc(run, cur);
    }
}
template <int... C> __device__ __forceinline__ void cand_all(std::integer_sequence<int, C...>, const float (&v1)[16], const float (&v2)[16], int (&cur)[16], int (&run)[16]) { (cand_step<C>(v1, v2, cur, run), ...); }
__device__ __forceinline__ void top16_of_128(const float* __restrict__ s, int (&run)[16]) {
#pragma unroll 1
    for (int g = 0; g < 8; ++g) {
        int cur[16];
#pragma unroll
        for (int q = 0; q < 4; ++q) { const float4 v = ((const float4*)s)[g * 4 + q];
            cur[4 * q + 0] = (ord_key(v.x) & ~127) | (g * 16 + 4 * q + 0); cur[4 * q + 1] = (ord_key(v.y) & ~127) | (g * 16 + 4 * q + 1);
            cur[4 * q + 2] = (ord_key(v.z) & ~127) | (g * 16 + 4 * q + 2); cur[4 * q + 3] = (ord_key(v.w) & ~127) | (g * 16 + 4 * q + 3); }
        sort16_desc(cur);
        if (g == 0) {
#pragma unroll
            for (int i = 0; i < 16; ++i) run[i] = cur[i];
        } else merge16_desc(run, cur);
    }
}
__device__ __forceinline__ int lut16(const int (&p)[4], int i) {
    const int r = i >> 2; const int w = r == 0 ? p[0] : (r == 1 ? p[1] : (r == 2 ? p[2] : p[3]));
    return (w >> ((i & 3) * 8)) & 127;
}
__device__ __forceinline__ int shxi(int v, int m, int lane) { return __builtin_amdgcn_ds_bpermute((lane ^ m) << 2, v); }
__device__ __forceinline__ void xmerge16(int (&a)[16], int m, int lane) { int b[16];
#pragma unroll
    for (int i = 0; i < 16; ++i) b[i] = shxi(a[i], m, lane);
    merge16_desc(a, b); }
__device__ __forceinline__ void st_half(const bf16_t* __restrict__ qrow  , const unsigned char* kl  , int (&top)[16], int lane) {
    const int r = lane & 15, q = lane >> 4;
    bf16x8 bq[4];
#pragma unroll
    for (int ks = 0; ks < 4; ++ks) bq[ks] = *(const bf16x8*)(qrow + ks * 32);
    int g0[16];
#pragma unroll
    for (int i = 0; i < 16; ++i) g0[i] = (int)0x80000000;
#pragma unroll 1
    for (int grp = 0; grp < 2; ++grp) {
        f32x4 acc[4];
#pragma unroll
        for (int tl = 0; tl < 4; ++tl) { acc[tl] = (f32x4){0.f, 0.f, 0.f, 0.f};
#pragma unroll
            for (int ks = 0; ks < 4; ++ks) { const int row = (grp * 4 + tl) * 16 + r; const bf16x8 ak = *(const bf16x8*)(kl + row * 256 + ((((ks * 4 + q) ^ r) & 15) << 4));
                acc[tl] = __builtin_amdgcn_mfma_f32_16x16x32_bf16(ak, bq[ks], acc[tl], 0, 0, 0); } }
        int g1[16];
#pragma unroll
        for (int tl = 0; tl < 4; ++tl)
#pragma unroll
            for (int j = 0; j < 4; ++j) g1[tl * 4 + j] = (ord_key(acc[tl][j]) & ~127) | ((grp * 4 + tl) * 16 + q * 4 + j);
        sort16_desc(g1); merge16_desc(g0, g1);
    }
    xmerge16(g0, 16, lane); xmerge16(g0, 32, lane);
#pragma unroll
    for (int i = 0; i < 16; ++i) top[i] = g0[i];
}
__device__ __forceinline__ void st_tokens16(const bf16_t* __restrict__ Qq, const unsigned char* klds  , int* __restrict__ IDX, float* __restrict__ GATE, int t0, int head, int lane) {
    const int c = lane & 15, q = lane >> 4, t = t0 + c;
    const bf16_t* qrow = Qq + (size_t)t * 2048 + head * 256 + q * 8;
    int k1[16], k2[16];
    st_half(qrow, klds, k1, lane);
    st_half(qrow + 128, klds + 32768, k2, lane);
    float v1[16], v2[16]; int id1[4] = {0, 0, 0, 0}, id2[4] = {0, 0, 0, 0};
#pragma unroll
    for (int i = 0; i < 16; ++i) { v1[i] = key_val(k1[i] & ~127); v2[i] = key_val(k2[i] & ~127); id1[i >> 2] |= (k1[i] & 127) << ((i & 3) * 8); id2[i >> 2] |= (k2[i] & 127) << ((i & 3) * 8); }
    int run[16];
    { int cur[16]; cand_all(std::make_integer_sequence<int, NCAND>{}, v1, v2, cur, run); }
    float e[16], sum = 0.f; const float s0 = key_val(run[0] & ~255);
#pragma unroll
    for (int i = 0; i < 16; ++i) { e[i] = __expf(key_val(run[i] & ~255) - s0); sum += e[i]; }
    const float inv = 1.0f / sum;
    int f4[4]; float e4[4];
#pragma unroll
    for (int j = 0; j < 4; ++j) { f4[j] = q == 0 ? run[j] : (q == 1 ? run[4 + j] : (q == 2 ? run[8 + j] : run[12 + j])); e4[j] = q == 0 ? e[j] : (q == 1 ? e[4 + j] : (q == 2 ? e[8 + j] : e[12 + j])); }
    int4 iv; float4 gv;
    { const int f = f4[0] & 255; iv.x = lut16(id1, f >> 4) * 128 + lut16(id2, f & 15); gv.x = e4[0] * inv; }
    { const int f = f4[1] & 255; iv.y = lut16(id1, f >> 4) * 128 + lut16(id2, f & 15); gv.y = e4[1] * inv; }
    { const int f = f4[2] & 255; iv.z = lut16(id1, f >> 4) * 128 + lut16(id2, f & 15); gv.z = e4[2] * inv; }
    { const int f = f4[3] & 255; iv.w = lut16(id1, f >> 4) * 128 + lut16(id2, f & 15); gv.w = e4[3] * inv; }
    ((int4*)(IDX + (size_t)t * NSEL + head * 16))[q] = iv; ((float4*)(GATE + (size_t)t * NSEL + head * 16))[q] = gv;
}

__device__ __forceinline__ void conv_elem8(const bf16_t* __restrict__ Bg, const bf16_t* __restrict__ Vv, const float* __restrict__ cw, bf16_t* __restrict__ Aa, size_t i) {
    const int t = (int)(i >> 7), c8 = (int)(i & 127), s = t & (SEQ - 1);
    const uint4 b = ((const uint4*)Bg)[i], v2 = ((const uint4*)Vv)[i];
    const uint4 v1 = ((const uint4*)Vv)[s >= 1 ? i - 128 : i], v0 = ((const uint4*)Vv)[s >= 2 ? i - 256 : i];
    const float m1 = s >= 1 ? 1.f : 0.f, m0 = s >= 2 ? 1.f : 0.f;
    const float4 w0a = ((const float4*)cw)[2 * c8], w0b = ((const float4*)cw)[2 * c8 + 1], w1a = ((const float4*)(cw + D))[2 * c8], w1b = ((const float4*)(cw + D))[2 * c8 + 1],
                 w2a = ((const float4*)(cw + 2 * D))[2 * c8], w2b = ((const float4*)(cw + 2 * D))[2 * c8 + 1];
    uint4 o;
    o.x = pk2(bf_lo(b.x) * (m0 * w0a.x * bf_lo(v0.x) + m1 * w1a.x * bf_lo(v1.x) + w2a.x * bf_lo(v2.x)), bf_hi(b.x) * (m0 * w0a.y * bf_hi(v0.x) + m1 * w1a.y * bf_hi(v1.x) + w2a.y * bf_hi(v2.x)));
    o.y = pk2(bf_lo(b.y) * (m0 * w0a.z * bf_lo(v0.y) + m1 * w1a.z * bf_lo(v1.y) + w2a.z * bf_lo(v2.y)), bf_hi(b.y) * (m0 * w0a.w * bf_hi(v0.y) + m1 * w1a.w * bf_hi(v1.y) + w2a.w * bf_hi(v2.y)));
    o.z = pk2(bf_lo(b.z) * (m0 * w0b.x * bf_lo(v0.z) + m1 * w1b.x * bf_lo(v1.z) + w2b.x * bf_lo(v2.z)), bf_hi(b.z) * (m0 * w0b.y * bf_hi(v0.z) + m1 * w1b.y * bf_hi(v1.z) + w2b.y * bf_hi(v2.z)));
    o.w = pk2(bf_lo(b.w) * (m0 * w0b.z * bf_lo(v0.w) + m1 * w1b.z * bf_lo(v1.w) + w2b.z * bf_lo(v2.w)), bf_hi(b.w) * (m0 * w0b.w * bf_hi(v0.w) + m1 * w1b.w * bf_hi(v1.w) + w2b.w * bf_hi(v2.w)));
    ((uint4*)Aa)[i] = o;
}
template <int W>
__device__ __forceinline__ void pool_elem8(const bf16_t* __restrict__ Uu, bf16_t* __restrict__ Pp, int t, int c8  ) {
    const int s = t & (SEQ - 1);
    const size_t i = (size_t)t * 128 + c8;
    uint4 r[W];
#pragma unroll
    for (int k = 0; k < W; ++k) r[k] = ((const uint4*)Uu)[k <= s ? i - (size_t)k * 128 : i];
    float a[8] = {0, 0, 0, 0, 0, 0, 0, 0};
#pragma unroll
    for (int k = 0; k < W; ++k) { const float m = k <= s ? 1.f : 0.f;
        a[0] += m * bf_lo(r[k].x); a[1] += m * bf_hi(r[k].x); a[2] += m * bf_lo(r[k].y); a[3] += m * bf_hi(r[k].y); a[4] += m * bf_lo(r[k].z); a[5] += m * bf_hi(r[k].z); a[6] += m * bf_lo(r[k].w); a[7] += m * bf_hi(r[k].w); }
    const float inv = 1.0f / (float)(s + 1 < W ? s + 1 : W);
    uint4 o;
    o.x = pk2(a[0] * inv - bf_lo(r[0].x), a[1] * inv - bf_hi(r[0].x)); o.y = pk2(a[2] * inv - bf_lo(r[0].y), a[3] * inv - bf_hi(r[0].y));
    o.z = pk2(a[4] * inv - bf_lo(r[0].z), a[5] * inv - bf_hi(r[0].z)); o.w = pk2(a[6] * inv - bf_lo(r[0].w), a[7] * inv - bf_hi(r[0].w));
    ((uint4*)Pp)[i] = o;
}

__device__ __forceinline__ void topk_pair(const float* __restrict__ S, int* __restrict__ IDX, float* __restrict__ GATE, size_t p) {
    int k1[16], k2[16];
    top16_of_128(S + p * 256, k1);
    top16_of_128(S + p * 256 + 128, k2);
    float v1[16], v2[16]; int id1[4] = {0, 0, 0, 0}, id2[4] = {0, 0, 0, 0};
#pragma unroll
    for (int i = 0; i < 16; ++i) { v1[i] = key_val(k1[i] & ~127); v2[i] = key_val(k2[i] & ~127); id1[i >> 2] |= (k1[i] & 127) << ((i & 3) * 8); id2[i >> 2] |= (k2[i] & 127) << ((i & 3) * 8); }
    int run[16];
    { int cur[16]; cand_all(std::make_integer_sequence<int, NCAND>{}, v1, v2, cur, run); }
    float sc[16], e[16], sum = 0.f;
#pragma unroll
    for (int i = 0; i < 16; ++i) sc[i] = key_val(run[i] & ~255);
#pragma unroll
    for (int i = 0; i < 16; ++i) { e[i] = __expf(sc[i] - sc[0]); sum += e[i]; }
    const float inv = 1.0f / sum;
    int* io = IDX + p * 16; float* go = GATE + p * 16;
#pragma unroll
    for (int q = 0; q < 4; ++q) {
        int4 iv; float4 gv;
        { const int f = run[4 * q + 0] & 255; iv.x = lut16(id1, f >> 4) * 128 + lut16(id2, f & 15); gv.x = e[4 * q + 0] * inv; }
        { const int f = run[4 * q + 1] & 255; iv.y = lut16(id1, f >> 4) * 128 + lut16(id2, f & 15); gv.y = e[4 * q + 1] * inv; }
        { const int f = run[4 * q + 2] & 255; iv.z = lut16(id1, f >> 4) * 128 + lut16(id2, f & 15); gv.z = e[4 * q + 2] * inv; }
        { const int f = run[4 * q + 3] & 255; iv.w = lut16(id1, f >> 4) * 128 + lut16(id2, f & 15); gv.w = e[4 * q + 3] * inv; }
        ((int4*)io)[q] = iv; ((float4*)go)[q] = gv;
    }
}

#define LOAD_IDS16(id, p) { const int4 _a = (p)[0], _b = (p)[1], _c = (p)[2], _d = (p)[3]; id[0] = _a.x; id[1] = _a.y; id[2] = _a.z; id[3] = _a.w; id[4] = _b.x; id[5] = _b.y; id[6] = _b.z; id[7] = _b.w; \
    id[8] = _c.x; id[9] = _c.y; id[10] = _c.z; id[11] = _c.w; id[12] = _d.x; id[13] = _d.y; id[14] = _d.z; id[15] = _d.w; }
#define FP8X2(w, hi) __builtin_amdgcn_cvt_pk_f32_fp8((int)(w), hi)
__device__ __forceinline__ void peer_u_tokens(const bf16_t* __restrict__ H2, const int* __restrict__ IDX, const unsigned char* __restrict__ tab, float* __restrict__ PARTs, int s, int t0, int t1, int lane) {
    const int g = lane >> 3, j = lane & 7;
    const unsigned char* tb = tab + j * 16;
    const bool b4 = (j & 4) != 0, b2 = (j & 2) != 0, b1 = (j & 1) != 0;
    for (int t = t0; t < t1; ++t) {
        int id[16];
        LOAD_IDS16(id, (const int4*)(IDX + (size_t)t * NSEL + g * 16));
        const uint4 h0 = *(const uint4*)(H2 + (size_t)t * D + s * 128 + j * 16), h1 = *(const uint4*)(H2 + (size_t)t * D + s * 128 + j * 16 + 8);
        uint4 r[16];
#pragma unroll
        for (int i = 0; i < 16; ++i) r[i] = *(const uint4*)(tb + (unsigned)id[i] * 128u);
        const f32x2 hp[8] = {{bf_lo(h0.x), bf_hi(h0.x)}, {bf_lo(h0.y), bf_hi(h0.y)}, {bf_lo(h0.z), bf_hi(h0.z)}, {bf_lo(h0.w), bf_hi(h0.w)},
                             {bf_lo(h1.x), bf_hi(h1.x)}, {bf_lo(h1.y), bf_hi(h1.y)}, {bf_lo(h1.z), bf_hi(h1.z)}, {bf_lo(h1.w), bf_hi(h1.w)}};
        float a[16];
#pragma unroll
        for (int i = 0; i < 16; ++i) {
            f32x2 sacc = hp[0] * FP8X2(r[i].x, false);
            sacc += hp[1] * FP8X2(r[i].x, true); sacc += hp[2] * FP8X2(r[i].y, false); sacc += hp[3] * FP8X2(r[i].y, true);
            sacc += hp[4] * FP8X2(r[i].z, false); sacc += hp[5] * FP8X2(r[i].z, true); sacc += hp[6] * FP8X2(r[i].w, false); sacc += hp[7] * FP8X2(r[i].w, true);
            a[i] = sacc.x + sacc.y; }
        float b8[8], c4[4], d2[2];
#pragma unroll
        for (int i = 0; i < 8; ++i) { const float keep = b4 ? a[i + 8] : a[i], send = b4 ? a[i] : a[i + 8]; b8[i] = keep + shx(send, 4, lane); }
#pragma unroll
        for (int i = 0; i < 4; ++i) { const float keep = b2 ? b8[i + 4] : b8[i], send = b2 ? b8[i] : b8[i + 4]; c4[i] = keep + shx(send, 2, lane); }
#pragma unroll
        for (int i = 0; i < 2; ++i) { const float keep = b1 ? c4[i + 2] : c4[i], send = b1 ? c4[i] : c4[i + 2]; d2[i] = keep + shx(send, 1, lane); }
        *(float2*)(PARTs + (size_t)t * NSEL + lane * 2) = make_float2(d2[0], d2[1]);
    }
}
__device__ __forceinline__ void peer_v_tokens(const float* __restrict__ W, const int* __restrict__ IDX, const unsigned char* __restrict__ tab, const float* __restrict__ Xin, const float* __restrict__ g2,
                                              float* __restrict__ Xout, int s, int t0, int t1, int lane) {
    const int g = lane >> 3, j = lane & 7;
    const unsigned char* tb = tab + j * 16;
    const bool g4 = (g & 4) != 0, g2b = (g & 2) != 0, g1 = (g & 1) != 0;
    const int col = s * 128 + j * 16 + 2 * g;
    for (int t = t0; t < t1; ++t) {
        int id[16]; float w[16];
        LOAD_IDS16(id, (const int4*)(IDX + (size_t)t * NSEL + g * 16));
        { const float4* wp = (const float4*)(W + (size_t)t * NSEL + g * 16); const float4 a = wp[0], b = wp[1], c = wp[2], d = wp[3];
          w[0] = a.x; w[1] = a.y; w[2] = a.z; w[3] = a.w; w[4] = b.x; w[5] = b.y; w[6] = b.z; w[7] = b.w; w[8] = c.x; w[9] = c.y; w[10] = c.z; w[11] = c.w; w[12] = d.x; w[13] = d.y; w[14] = d.z; w[15] = d.w; }
        uint4 r[16];
#pragma unroll
        for (int i = 0; i < 16; ++i) r[i] = *(const uint4*)(tb + (unsigned)id[i] * 128u);
        f32x2 acc[8];
#pragma unroll
        for (int k = 0; k < 8; ++k) acc[k] = (f32x2){0.f, 0.f};
#pragma unroll
        for (int i = 0; i < 16; ++i) { const f32x2 ww = {w[i], w[i]};
            acc[0] += ww * FP8X2(r[i].x, false); acc[1] += ww * FP8X2(r[i].x, true); acc[2] += ww * FP8X2(r[i].y, false); acc[3] += ww * FP8X2(r[i].y, true);
            acc[4] += ww * FP8X2(r[i].z, false); acc[5] += ww * FP8X2(r[i].z, true); acc[6] += ww * FP8X2(r[i].w, false); acc[7] += ww * FP8X2(r[i].w, true); }
        f32x2 b4[4], c2[2];
#pragma unroll
        for (int i = 0; i < 4; ++i) { const f32x2 keep = g4 ? acc[i + 4] : acc[i], send = g4 ? acc[i] : acc[i + 4]; b4[i] = (f32x2){keep.x + shx(send.x, 32, lane), keep.y + shx(send.y, 32, lane)}; }
#pragma unroll
        for (int i = 0; i < 2; ++i) { const f32x2 keep = g2b ? b4[i + 2] : b4[i], send = g2b ? b4[i] : b4[i + 2]; c2[i] = (f32x2){keep.x + shx(send.x, 16, lane), keep.y + shx(send.y, 16, lane)}; }
        const f32x2 keep = g1 ? c2[1] : c2[0], send = g1 ? c2[0] : c2[1];
        const f32x2 o = {keep.x + shx(send.x, 8, lane), keep.y + shx(send.y, 8, lane)};
        const int b = t / SEQ;
        const float2 xi = *(const float2*)(Xin + (size_t)t * D + col), gg = *(const float2*)(g2 + (size_t)b * 6144 + col);
        *(float2*)(Xout + (size_t)t * D + col) = make_float2(xi.x + gg.x * o.x, xi.y + gg.y * o.y);
    }
}
struct PeerOwn { int first_slice, slice_step, t0, t1; };
__device__ __forceinline__ PeerOwn peer_own(unsigned* bar, unsigned x, unsigned rank, int wid) {
    unsigned nx = 0, px = 0, nloc = 1;
#pragma unroll
    for (unsigned jx = 0; jx < 16; ++jx) { const unsigned cnt = xb_ld(&bar[XB_XCNT(jx)]); if (jx == x) { px = nx; nloc = cnt ? cnt : 1u; } nx += cnt ? 1u : 0u; }
    if (rank >= nloc) rank = nloc - 1;
    const unsigned nw = nloc * (NT / 64), wr = rank * (NT / 64) + wid;
    PeerOwn o; o.first_slice = (int)px; o.slice_step = (int)(nx ? nx : 1u);
    o.t0 = (int)(((unsigned long long)wr * T) / nw); o.t1 = (int)(((unsigned long long)(wr + 1) * T) / nw);
    return o;
}

constexpr int LDS_MISC = pg8::STAGE_BYTES;
constexpr int LDS_BYTES = pg8::STAGE_BYTES + 256;
extern __shared__ __attribute__((aligned(16))) unsigned char smem[];
#ifndef PROBE_ID
#define PROBE_ID 0
#endif
__global__ void __launch_bounds__(NT, 2) mega_fwd(Params p) {
    unsigned char* lds = smem;
    PG8_LAS unsigned char* ldsl = (PG8_LAS unsigned char*)smem;
    volatile LAS unsigned* bst = (volatile LAS unsigned*)(smem + LDS_MISC);
    unsigned char* ws = p.ws;
    if (threadIdx.x == 0) { bst[0] = 0u; bst[1] = 0u; bst[2] = xb_add((unsigned*)(ws + WS_CTL) + XB_RANK(xb_xcc_id()), 1u); }
    __syncthreads();
    const XcdBarrier bar = xcd_barrier_post((unsigned*)(ws + WS_CTL), bst);
#define GRID_SYNC() xcd_barrier(bar)
#define PH_BEGIN(id) for (int _rep = 0; _rep < ((PROBE_ID) == (id) ? 3 : 1); ++_rep) {
#define PH_END() GRID_SYNC(); }
    if (threadIdx.x < 20) ((const float**)(ws + WS_CTL + PTAB_OFF))[threadIdx.x] = threadIdx.x < 19 ? p.in[threadIdx.x] : (const float*)p.out;
#define INP(i) ld_uniform_ptr(ws + WS_CTL + PTAB_OFF, (i))
    unsigned char* U8 = ws + WS_U16; unsigned char* V8 = ws + WS_V16; float* USC = (float*)(ws + WS_USC); float* VSC = (float*)(ws + WS_VSC);
    bf16_t* Wci = (bf16_t*)(ws + WS_WCI); bf16_t* Wco = (bf16_t*)(ws + WS_WCO); bf16_t* Wpi = (bf16_t*)(ws + WS_WPI); bf16_t* Wpg = (bf16_t*)(ws + WS_WPG); bf16_t* Wpo = (bf16_t*)(ws + WS_WPO);
    bf16_t* Wq = (bf16_t*)(ws + WS_WQ); bf16_t* K12 = (bf16_t*)(ws + WS_KBD);
    float* mod = (float*)(ws + WS_MOD);
    bf16_t* Hh = (bf16_t*)(ws + WS_HH); bf16_t* Bg = (bf16_t*)(ws + WS_BG); bf16_t* Vv = (bf16_t*)(ws + WS_VV); bf16_t* Aa = (bf16_t*)(ws + WS_AA);
    float* XA = (float*)(ws + WS_XA); bf16_t* H2 = (bf16_t*)(ws + WS_H2); bf16_t* Qq = (bf16_t*)(ws + WS_QQ);
    int* IDX = (int*)(ws + WS_IDX); float* GATE = (float*)(ws + WS_GATE);
    float* PART = (float*)(ws + WS_HH);
    float* Wg = (float*)(ws + WS_QQ);
    const int G = gridDim.x;
    pg8::StaticOrder so;

    PH_BEGIN(1)
        constexpr int N_UV = 2 * NE / 16;
        constexpr int I_U = 0, I_V = I_U + N_UV, I_KB = I_V + N_UV, I_CI = I_KB + 4, I_CO = I_CI + 48 * 16, I_PI = I_CO + 256, I_PG = I_PI + 256, I_PO = I_PG + 64,
                      I_WQ = I_PO + 256, I_MOD = I_WQ + 2 * 32 * 16, I_END = I_MOD + 192;
        float* cact = (float*)(lds + 32768);
        if ((int)blockIdx.x + ((I_END - I_MOD + G - 1) / G) * 0 >= 0) { const int tid = otid(); for (int i = tid; i < 8 * D; i += NT) { const float v = p.in[1][i]; cact[i] = v / (1.0f + __expf(-v)); } }
        __syncthreads();
        for (int w0 = blockIdx.x; w0 < I_END; w0 += G) {
            const int w = (w0 < 192) ? (I_MOD + w0) : (w0 - 192);
            if (w < I_V) { const int tid = otid(); cvt_rows_fp8(p.in[16], U8, USC, (w - I_U) * 16 + (tid >> 6) * 2, tid & 63); }
            else if (w < I_KB) { const int tid = otid(); cvt_rows_fp8(p.in[17], V8, VSC, (w - I_V) * 16 + (tid >> 6) * 2, tid & 63); }
            else if (w < I_CI) k12_item(p.in[14], p.in[15], K12, w - I_KB);
            else if (w < I_CO) { const int i = w - I_CI; transpose_tile<1>(p.in[6], Wci, D, 3072, i % 48, i / 48, (float*)lds); }
            else if (w < I_PI) { const int i = w - I_CO; transpose_tile<0>(p.in[8], Wco, D, D, i % 16, i / 16, (float*)lds); }
            else if (w < I_PG) { const int i = w - I_PI; transpose_tile<0>(p.in[9], Wpi, D, D, i % 16, i / 16, (float*)lds); }
            else if (w < I_PO) { const int i = w - I_PG, g = i >> 4, j = i & 15; transpose_tile<0>(p.in[10] + (size_t)g * 65536, Wpg + (size_t)g * 65536, 256, 256, j % 4, j / 4, (float*)lds); }
            else if (w < I_WQ) { const int i = w - I_PO; transpose_tile<0>(p.in[12], Wpo, D, D, i % 16, i / 16, (float*)lds); }
            else if (w < I_MOD) { const int i = w - I_WQ, l = i >> 9, j = i & 511; transpose_tile<0>(p.in[13] + (size_t)l * D * 2048, Wq + (size_t)l * 2048 * D, D, 2048, j % 32, j / 32, (float*)lds); }
            else mod_item(cact, p.in[4], p.in[5], mod, w - I_MOD, (float*)lds);
        }
    PH_END()

    const float* xin = INP(0);
    for (int l = 0; l < 2; ++l) {
        const float* ml = mod + (size_t)l * 8 * 6144;
        float* x1 = XA; float* x2 = (float*)INP(19);
        PH_BEGIN(2) { const int tid = otid(); for (int r = blockIdx.x * 8 + (tid >> 6); r < T; r += G * 8) rmsnorm_row<0>(xin, INP(2) + l * D, ml + 0, ml + 1024, Hh, nullptr, r, tid & 63); } PH_END()
        if (l == 0) {
            PH_BEGIN(3) so.init(T, 3072, G, blockIdx.x); pg8::gemm_phase(ldsl, pg8::Gemm{Hh, Wci, D, D, D, 0}, so, EpiConvIn{Bg, Vv}); PH_END()
            PH_BEGIN(4) { const float* cw = INP(7); const size_t i0 = (size_t)blockIdx.x * NT + otid(), st = (size_t)G * NT;
                for (size_t i = i0; i < (size_t)T * D / 8; i += 2 * st) { conv_elem8(Bg, Vv, cw, Aa, i); if (i + st < (size_t)T * D / 8) conv_elem8(Bg, Vv, cw, Aa, i + st); } } PH_END()
            PH_BEGIN(3) so.init(T, D, G, blockIdx.x); pg8::gemm_phase(ldsl, pg8::Gemm{Aa, Wco, D, D, D, 0}, so, EpiResid{xin, x1, ml + 2048}); PH_END()
        } else {
            PH_BEGIN(3) so.init(T, D, G, blockIdx.x); pg8::gemm_phase(ldsl, pg8::Gemm{Hh, Wpi, D, D, D, 0}, so, EpiBf16{Bg, D, 0}); PH_END()
            PH_BEGIN(4) { const int tid = otid(), wv = tid >> 6, lane = tid & 63;
                for (int it = blockIdx.x * 8 + wv; it < (T / 2) * 4; it += G * 8) { const int grp = it & 3, t = (it >> 2) * 2 + (lane >> 5), c8 = grp * 32 + (lane & 31);
                    if (grp == 0) pool_elem8<2>(Bg, Vv, t, c8); else if (grp == 1) pool_elem8<4>(Bg, Vv, t, c8); else if (grp == 2) pool_elem8<8>(Bg, Vv, t, c8); else pool_elem8<16>(Bg, Vv, t, c8); } } PH_END()
            PH_BEGIN(3) so.init(T, D, G, blockIdx.x); pg8::gemm_phase(ldsl, pg8::Gemm{Vv, Wpg, D, 256, 256, 512}, so, EpiScaleBf16{Aa, INP(11), D, 0}); PH_END()
            PH_BEGIN(3) so.init(T, D, G, blockIdx.x); pg8::gemm_phase(ldsl, pg8::Gemm{Aa, Wpo, D, D, D, 0}, so, EpiResid{xin, x1, ml + 2048}); PH_END()
        }
        PH_BEGIN(2) { const int tid = otid(); for (int r = blockIdx.x * 8 + (tid >> 6); r < T; r += G * 8) rmsnorm_row<0>(x1, INP(3) + l * D, ml + 3072, ml + 4096, H2, nullptr, r, tid & 63); } PH_END()
        PH_BEGIN(3) so.init(T, 2048, G, blockIdx.x); pg8::gemm_phase(ldsl, pg8::Gemm{H2, Wq + (size_t)l * 2048 * D, D, D, D, 0}, so, EpiBf16{Qq, 2048, 0}); PH_END()
        PH_BEGIN(5) {
            const int tid = otid(), lane = tid & 63, wv = tid >> 6;
            __syncthreads();
#pragma unroll
            for (int i = 0; i < 8; ++i) { const int ch = i * NT + tid, half = ch >> 11, n = (ch >> 4) & 127, cc = ch & 15;
                *(uint4*)(lds + half * 32768 + n * 256 + ((cc ^ (n & 15)) << 4)) = ((const uint4*)(K12 + (size_t)l * 32768))[ch]; }
            __syncthreads();
            for (int it = blockIdx.x * 8 + wv; it < (T / 16) * 8; it += G * 8) st_tokens16(Qq, lds, IDX, GATE, (it >> 3) * 16, it & 7, lane);
        } PH_END()
        PH_BEGIN(7) {
            const int tid = otid(), lane = tid & 63;
            const PeerOwn own = peer_own(bar.bar, bar.x, bst[2], tid >> 6);
            for (int sl = own.first_slice; sl < 8; sl += own.slice_step)
                peer_u_tokens(H2, IDX, U8 + ((size_t)l * 8 + sl) * NE * 128, PART + (size_t)sl * T * NSEL, sl, own.t0, own.t1, lane);
        } PH_END()
        PH_BEGIN(8) for (size_t i = (size_t)blockIdx.x * NT + otid(); i < (size_t)T * NSEL / 4; i += (size_t)G * NT) {
            float4 a = ((const float4*)PART)[i];
#pragma unroll
            for (int sl = 1; sl < 8; ++sl) { const float4 q = ((const float4*)(PART + (size_t)sl * T * NSEL))[i]; a.x += q.x; a.y += q.y; a.z += q.z; a.w += q.w; }
            const float4 gt = ((const float4*)GATE)[i]; const int4 id = ((const int4*)IDX)[i];
            const float* us = USC + (size_t)l * NE; const float* vs = VSC + (size_t)l * NE;
            a.x *= us[id.x]; a.y *= us[id.y]; a.z *= us[id.z]; a.w *= us[id.w];
            float4 o;
            o.x = gt.x * vs[id.x] * 0.5f * a.x * (1.0f + erff(a.x * 0.70710678118654752f)); o.y = gt.y * vs[id.y] * 0.5f * a.y * (1.0f + erff(a.y * 0.70710678118654752f));
            o.z = gt.z * vs[id.z] * 0.5f * a.z * (1.0f + erff(a.z * 0.70710678118654752f)); o.w = gt.w * vs[id.w] * 0.5f * a.w * (1.0f + erff(a.w * 0.70710678118654752f));
            ((float4*)Wg)[i] = o;
        } PH_END()
        PH_BEGIN(9) {
            const int tid = otid(), lane = tid & 63;
            const PeerOwn own = peer_own(bar.bar, bar.x, bst[2], tid >> 6);
            for (int sl = own.first_slice; sl < 8; sl += own.slice_step)
                peer_v_tokens(Wg, IDX, V8 + ((size_t)l * 8 + sl) * NE * 128, x1, ml + 5120, x2, sl, own.t0, own.t1, lane);
        } PH_END()
        xin = x2;
    }
    { float* XB = (float*)INP(19); const float* fg = INP(18); const int tid = otid(); for (int r = blockIdx.x * 8 + (tid >> 6); r < T; r += G * 8) rmsnorm_row<1>(XB, fg, nullptr, nullptr, nullptr, XB, r, tid & 63); }
}

extern "C" void kernel_launch(void* const* d_in, const int* in_sizes, int n_in, void* d_out, int out_size, void* d_ws, size_t ws_size, hipStream_t stream) {
    static int grid = 0;
    if (grid == 0) {
        if (n_in != 19 || ws_size < WS_END) { fprintf(stderr, "kernel_launch: expected 19 inputs and >= %zu bytes of workspace (got %d, %zu)\n", (size_t)WS_END, n_in, ws_size); grid = -1; return; }
        int dev = 0, cus = 0, per_cu = 0;
        (void)hipGetDevice(&dev);
        (void)hipDeviceGetAttribute(&cus, hipDeviceAttributeMultiprocessorCount, dev);
        if (hipFuncSetAttribute((const void*)mega_fwd, hipFuncAttributeMaxDynamicSharedMemorySize, LDS_BYTES) != hipSuccess) { fprintf(stderr, "kernel_launch: cannot get %d bytes of dynamic LDS\n", LDS_BYTES); grid = -1; return; }
        (void)hipOccupancyMaxActiveBlocksPerMultiprocessor(&per_cu, (const void*)mega_fwd, NT, LDS_BYTES);
        if (per_cu < 1) { fprintf(stderr, "kernel_launch: occupancy query says %d blocks per CU\n", per_cu); grid = -1; return; }
        grid = cus;
        fprintf(stderr, "kernel_launch: %d CUs, occupancy query %d block(s) per CU, grid %d\n", cus, per_cu, grid);
    }
    if (grid < 0) return;
    (void)hipMemsetAsync((unsigned char*)d_ws + WS_CTL, 0, CTL_BYTES, stream);
    Params p{};
    for (int i = 0; i < 19; ++i) p.in[i] = (const float*)d_in[i];
    p.out = (float*)d_out; p.ws = (unsigned char*)d_ws;
    void* args[] = {&p};
    hipError_t e = hipLaunchCooperativeKernel((const void*)mega_fwd, dim3(grid), dim3(NT), args, LDS_BYTES, stream);
    if (e != hipSuccess) fprintf(stderr, "kernel_launch: cooperative launch failed: %s (grid %d)\n", hipGetErrorString(e), grid);
}
```

```cpp
#include <hip/hip_runtime.h>
#include <cstdio>
#include <cstdint>
#include <utility>

typedef unsigned short bf16_t;
typedef short bf16x8 __attribute__((ext_vector_type(8)));
typedef float f32x4 __attribute__((ext_vector_type(4)));
typedef float f32x2 __attribute__((ext_vector_type(2)));
typedef unsigned u32x2 __attribute__((ext_vector_type(2)));
constexpr int NT = 512;

constexpr int D = 1024, NB = 8, SEQ = 2048, T = NB * SEQ;
constexpr int NE = 16384, NH = 8, TOPK = 16, NSEL = NH * TOPK;
constexpr float EPS = 1e-6f;

__device__ __forceinline__ unsigned f2bf(float f) { unsigned u = __builtin_bit_cast(unsigned, f); return (u + 0x7fffu + ((u >> 16) & 1u)) >> 16; }
__device__ __forceinline__ unsigned pk2(float lo, float hi) { return f2bf(lo) | (f2bf(hi) << 16); }
__device__ __forceinline__ float bf_lo(unsigned u) { return __builtin_bit_cast(float, u << 16); }
__device__ __forceinline__ float bf_hi(unsigned u) { return __builtin_bit_cast(float, u & 0xffff0000u); }
__device__ __forceinline__ int otid() { int t = threadIdx.x; asm volatile("" : "+v"(t)); return t; }
__device__ __forceinline__ const float* ld_uniform_ptr(const unsigned char* tab, int i) {
    const unsigned long long v = ((const unsigned long long*)tab)[i];
    const unsigned lo = __builtin_amdgcn_readfirstlane((unsigned)v), hi = __builtin_amdgcn_readfirstlane((unsigned)(v >> 32));
    return (const float*)(((unsigned long long)hi << 32) | lo);
}
__device__ __forceinline__ float shx(float v, int m, int lane) { return __builtin_bit_cast(float, __builtin_amdgcn_ds_bpermute((lane ^ m) << 2, __builtin_bit_cast(int, v))); }
__device__ __forceinline__ float wave_sum(float v, int lane) {
#pragma unroll
    for (int o = 32; o > 0; o >>= 1) v += shx(v, o, lane);
    return v;
}

#define XB_TMO      128
#define XB_XCNT(j)  (256  + 64 * (j))
#define XB_XSUB(j)  (1280 + 64 * (j))
#define XB_XGEN(j)  (2304 + 64 * (j))
#define XB_TOP      3328
#define XB_TOPGEN   3392
#define XCD_BAR_WORDS 3456
#define XB_RANK(j)  (3584 + 64 * (j))
#define CTL_BYTES 32768
#define PTAB_OFF 24576
#define XB_SPIN_CAP (1u << 18)
#define LAS __attribute__((address_space(3)))
__device__ __forceinline__ unsigned xb_ld(unsigned* p)              { return __hip_atomic_load(p, __ATOMIC_RELAXED, __HIP_MEMORY_SCOPE_AGENT); }
__device__ __forceinline__ unsigned xb_add(unsigned* p, unsigned v) { return __hip_atomic_fetch_add(p, v, __ATOMIC_RELAXED, __HIP_MEMORY_SCOPE_AGENT); }
__device__ __forceinline__ unsigned xb_xcc_id() { return (unsigned)__builtin_amdgcn_s_getreg((3 << 11) | 20) & 0xFu; }
#define XB_SPIN(cond, bar) do { unsigned _sp = 0; while (cond) { __builtin_amdgcn_s_sleep(1); \
    if ((++_sp & 255u) == 0u) { if (xb_ld(&(bar)[XB_TMO])) break; if (_sp > XB_SPIN_CAP) { atomicAdd(&(bar)[XB_TMO], 1u); break; } } } } while (0)
struct XcdBarrier { unsigned* bar; unsigned x; volatile LAS unsigned* st; };
__device__ __forceinline__ XcdBarrier xcd_barrier_post(unsigned* bar, volatile LAS unsigned* st) {
    XcdBarrier b; b.bar = bar; b.x = xb_xcc_id(); b.st = st;
    if (threadIdx.x == 0) (void)xb_add(&bar[XB_XCNT(b.x)], 1u);
    return b;
}
__device__ __forceinline__ void xcd_barrier_complete(unsigned* bar, unsigned x, unsigned& nloc, unsigned& nx) {
    const unsigned G = gridDim.x * gridDim.y * gridDim.z;
    unsigned sum, cnt, mine, sp = 0u;
    for (;;) {
        sum = 0u; cnt = 0u; mine = 0u;
#pragma unroll
        for (unsigned j = 0; j < 16; ++j) { const unsigned c = xb_ld(&bar[XB_XCNT(j)]); sum += c; cnt += (c > 0u) ? 1u : 0u; mine = (j == x) ? c : mine; }
        if (sum == G) break;
        __builtin_amdgcn_s_sleep(1);
        if ((++sp & 255u) == 0u) { if (xb_ld(&bar[XB_TMO])) break; if (sp > XB_SPIN_CAP) { atomicAdd(&bar[XB_TMO], 1u); break; } }
    }
    nloc = mine > 0u ? mine : 1u; nx = cnt > 0u ? cnt : 1u;
}
__device__ __forceinline__ void xcd_barrier(const XcdBarrier& b) {
    asm volatile("s_waitcnt vmcnt(0)" ::: "memory");
    __syncthreads();
    if (threadIdx.x == 0) {
        unsigned* bar = b.bar;
        __builtin_amdgcn_s_waitcnt(0);
        unsigned nloc = b.st[0], nx = b.st[1];
        if (nloc == 0u) { xcd_barrier_complete(bar, b.x, nloc, nx); b.st[0] = nloc; b.st[1] = nx; }
        const unsigned old = xb_add(&bar[XB_XSUB(b.x)], 1u);
        const unsigned gen = old / nloc;
        if (old + 1u == (gen + 1u) * nloc) {
            __builtin_amdgcn_fence(__ATOMIC_RELEASE, "agent");
            asm volatile("s_waitcnt vmcnt(0)" ::: "memory");
            const unsigned og = xb_add(&bar[XB_TOP], 1u);
            const unsigned tg = og / nx;
            if (og + 1u == (tg + 1u) * nx) xb_add(&bar[XB_TOPGEN], 1u);
            else XB_SPIN(xb_ld(&bar[XB_TOPGEN]) == tg, bar);
            __builtin_amdgcn_fence(__ATOMIC_ACQUIRE, "agent");
            xb_add(&bar[XB_XGEN(b.x)], 1u);
            asm volatile("s_waitcnt vmcnt(0)" ::: "memory");
        } else {
            XB_SPIN(xb_ld(&bar[XB_XGEN(b.x)]) == gen, bar);
            __builtin_amdgcn_fence(__ATOMIC_ACQUIRE, "agent");
            asm volatile("s_waitcnt vmcnt(0)" ::: "memory");
        }
    }
    __syncthreads();
}

namespace pg8 {
#define PG8_LAS __attribute__((address_space(3)))
constexpr int BM = 256, BK = 64, HALF = 128, HTB = HALF * BK * 2  , STAGE_BYTES = 8 * HTB, NXCD = 8, WGM = 8;
__host__ __device__ __forceinline__ int lds_byte(int r, int c) { const int st = (r >> 4) * 2 + (c >> 5), rr = r & 15, cc = c & 31, ob = rr * 64 + cc * 2; return st * 1024 + (ob ^ (((ob >> 9) & 1) << 5)); }
__host__ __device__ __forceinline__ void stage_rc(int b, int& R, int& C) { const int st = b / 1024, sb = b % 1024, swz = sb ^ (((sb >> 9) & 1) << 5); R = (st >> 1) * 16 + swz / 64; C = (st & 1) * 32 + (swz % 64) / 2; }
__host__ __device__ __forceinline__ int perm32(int rho) { const int n = rho >> 4, i = rho & 15; return 8 * (i >> 2) + 4 * n + (i & 3); }

struct Unit { int pm, pn; };
struct Gemm { const bf16_t* A; const bf16_t* Bt; int lda, ldb, K, a_colstep; };
struct StaticOrder {
    int nM, nN, nwg, G, c;
    __host__ __device__ void init(int M, int N, int G_, int c_) { nM = M / BM; nN = N / BM; nwg = nM * nN; G = G_; c = c_; }
    __host__ __device__ bool next(int i, Unit& u) const {
        const long L = (long)i * G + c; if (L >= nwg) return false;
        int wgid = (int)L; { const int q = nwg / NXCD, r = nwg % NXCD, xcd = wgid % NXCD, off = wgid / NXCD; wgid = (xcd < r ? xcd * (q + 1) : r * (q + 1) + (xcd - r) * q) + off; }
        const int nig = WGM * nN, gid = wgid / nig, fm = gid * WGM, gsz = (nM - fm) < WGM ? (nM - fm) : WGM;
        u.pm = fm + ((wgid % nig) % gsz); u.pn = (wgid % nig) / gsz; return true;
    }
    __device__ __forceinline__ void a_ready(const Unit&) const {}
    __device__ __forceinline__ void done(const Unit&) const {}
};
template <class Epi, class Sched>
__device__ __forceinline__ void gemm_phase(PG8_LAS unsigned char* lds, const Gemm g, const Sched& S, const Epi& E) {
    const int tid = otid(), wid = __builtin_amdgcn_readfirstlane(tid >> 6), lane = tid & 63, wr = wid >> 2, wc = wid & 3, fr = lane & 15, fq = lane >> 4;
    const int K = g.K, nt = K / BK;
    unsigned voffA[2], voffB[2];
#pragma unroll
    for (int i = 0; i < 2; ++i) { int R, C; stage_rc(tid * 16 + i * 8192, R, C); const int Rb = Epi::PERM ? ((R & ~31) + perm32(R & 31)) : R;
        voffA[i] = (unsigned)(R * g.lda + C) * 2u; voffB[i] = (unsigned)(Rb * g.ldb + C) * 2u; }
    const size_t kstep = (size_t)(BK * 2);
    const size_t hstepA = (size_t)HALF * g.lda * 2, hstepB = (size_t)HALF * g.ldb * 2;
    const size_t tstepA = 2 * hstepA, tstepB = 2 * hstepB;
    const size_t acs = (size_t)g.a_colstep;
    const unsigned ldsw = (unsigned)wid * 1024u;
    const int aoff = lds_byte(wr * 64 + fr, fq * 8), boff = lds_byte(wc * 32 + fr, fq * 8);
#define PG8_SA(b, h) (((b) * 2 + (h)) * HTB)
#define PG8_SB(b, h) ((4 + (b) * 2 + (h)) * HTB)
#define PG8_STAGE(bufoff, gbase, voff) do { _Pragma("unroll") for (int _i = 0; _i < 2; ++_i) \
        __builtin_amdgcn_global_load_lds((const unsigned*)((const char*)(gbase) + (voff)[_i]), (PG8_LAS unsigned*)(lds + (bufoff) + ldsw + _i * 8192), 16, 0, 0); } while (0)
#define PG8_LDA(dst, b, h) do { _Pragma("unroll") for (int m = 0; m < 4; ++m) _Pragma("unroll") for (int k = 0; k < 2; ++k) dst[m][k] = *(const PG8_LAS bf16x8*)(lds + PG8_SA(b, h) + aoff + m * 2048 + k * 1024); } while (0)
#define PG8_LDB(dst, b, h) do { _Pragma("unroll") for (int n = 0; n < 2; ++n) _Pragma("unroll") for (int k = 0; k < 2; ++k) dst[n][k] = *(const PG8_LAS bf16x8*)(lds + PG8_SB(b, h) + boff + n * 2048 + k * 1024); } while (0)
#define PG8_MMA(ai, bj, At, Bt) do { __builtin_amdgcn_s_setprio(1); _Pragma("unroll") for (int m = 0; m < 4; ++m) _Pragma("unroll") for (int n = 0; n < 2; ++n) _Pragma("unroll") for (int k = 0; k < 2; ++k) \
        acc[ai][bj][m][n] = __builtin_amdgcn_mfma_f32_16x16x32_bf16(Bt[n][k], At[m][k], acc[ai][bj][m][n], 0, 0, 0); __builtin_amdgcn_s_setprio(0); } while (0)
#define PG8_WAIT_V(n) asm volatile("s_waitcnt vmcnt(" #n ")" ::: "memory")
#define PG8_WAIT_L(n) asm volatile("s_waitcnt lgkmcnt(" #n ")" ::: "memory")
#define PG8_BAR __builtin_amdgcn_s_barrier()
#define PG8_SCHED __builtin_amdgcn_sched_barrier(0)
    Unit cur, nxt; int ui = 0;
    if (!S.next(0, cur)) return;
    f32x4 acc[2][2][4][2];
#pragma unroll
    for (int a = 0; a < 2; ++a)
#pragma unroll
        for (int b = 0; b < 2; ++b)
#pragma unroll
            for (int m = 0; m < 4; ++m)
#pragma unroll
                for (int n = 0; n < 2; ++n) acc[a][b][m][n] = (f32x4){0.f, 0.f, 0.f, 0.f};
    bf16x8 At[4][2], B0[2][2], B1[2][2];
    const char* cA = (const char*)g.A + (size_t)cur.pm * tstepA + (size_t)cur.pn * acs; const char* cB = (const char*)g.Bt + (size_t)cur.pn * tstepB;
    S.a_ready(cur);
    PG8_STAGE(PG8_SB(0, 0), cB, voffB); PG8_STAGE(PG8_SA(0, 0), cA, voffA); PG8_STAGE(PG8_SB(0, 1), cB + hstepB, voffB); PG8_STAGE(PG8_SA(0, 1), cA + hstepA, voffA);
    if (wr == 1) PG8_BAR;
    PG8_WAIT_V(4); PG8_BAR;
    PG8_STAGE(PG8_SB(1, 0), cB + kstep, voffB); PG8_STAGE(PG8_SA(1, 0), cA + kstep, voffA); PG8_STAGE(PG8_SB(1, 1), cB + hstepB + kstep, voffB);
    PG8_WAIT_V(6); PG8_BAR;
    for (;;) {
        const bool has_next = S.next(ui + 1, nxt);
        const char* nA = has_next ? (const char*)g.A + (size_t)nxt.pm * tstepA + (size_t)nxt.pn * acs : cA; const char* nB = has_next ? (const char*)g.Bt + (size_t)nxt.pn * tstepB : cB;
        for (int t = 0; t < nt; t += 2) {
            const bool last = (t == nt - 2);
            const char* a1 = cA + (size_t)(t + 1) * kstep;
            const char* a2 = last ? nA : cA + (size_t)(t + 2) * kstep; const char* b2 = last ? nB : cB + (size_t)(t + 2) * kstep;
            const char* a3 = a2 + kstep; const char* b3 = b2 + kstep;
            if (last && has_next) S.a_ready(nxt);
            PG8_LDB(B0, 0, 0); PG8_SCHED; PG8_LDA(At, 0, 0); PG8_STAGE(PG8_SA(1, 1), a1 + hstepA, voffA);
            PG8_WAIT_L(8); PG8_BAR; PG8_WAIT_L(0); PG8_MMA(0, 0, At, B0); PG8_BAR; PG8_SCHED;
            PG8_LDB(B1, 0, 1); PG8_STAGE(PG8_SB(0, 0), b2, voffB);
            PG8_BAR; PG8_WAIT_L(0); PG8_MMA(0, 1, At, B1); PG8_BAR;
            PG8_LDA(At, 0, 1); PG8_STAGE(PG8_SA(0, 0), a2, voffA);
            PG8_BAR; PG8_WAIT_L(0); PG8_MMA(1, 0, At, B0); PG8_BAR; PG8_SCHED;
            PG8_STAGE(PG8_SB(0, 1), b2 + hstepB, voffB);
            PG8_WAIT_V(6); PG8_BAR; PG8_MMA(1, 1, At, B1); PG8_BAR;
            PG8_LDB(B0, 1, 0); PG8_SCHED; PG8_LDA(At, 1, 0); PG8_STAGE(PG8_SA(0, 1), a2 + hstepA, voffA);
            PG8_WAIT_L(8); PG8_BAR; PG8_WAIT_L(0); PG8_MMA(0, 0, At, B0); PG8_BAR; PG8_SCHED;
            PG8_LDB(B1, 1, 1); PG8_STAGE(PG8_SB(1, 0), b3, voffB);
            PG8_BAR; PG8_WAIT_L(0); PG8_MMA(0, 1, At, B1); PG8_BAR;
            PG8_LDA(At, 1, 1); PG8_STAGE(PG8_SA(1, 0), a3, voffA);
            PG8_BAR; PG8_WAIT_L(0); PG8_MMA(1, 0, At, B0); PG8_BAR; PG8_SCHED;
            PG8_STAGE(PG8_SB(1, 1), b3 + hstepB, voffB);
            PG8_WAIT_V(6); PG8_BAR; PG8_MMA(1, 1, At, B1); PG8_BAR;
        }
            if constexpr (!Epi::AFTER_DRAIN) { int te = tid; asm volatile("" : "+v"(te));
            const int we = __builtin_amdgcn_readfirstlane(te >> 6), le = te & 63; E(acc, cur, we >> 2, we & 3, le & 15, le >> 4); S.done(cur); }
            if (!has_next) break;
#pragma unroll
        for (int a = 0; a < 2; ++a)
#pragma unroll
            for (int b = 0; b < 2; ++b)
#pragma unroll
                for (int m = 0; m < 4; ++m)
#pragma unroll
                    for (int n = 0; n < 2; ++n) acc[a][b][m][n] = (f32x4){0.f, 0.f, 0.f, 0.f};
        cur = nxt; cA = nA; cB = nB; ++ui;
    }
    PG8_WAIT_V(0);
    if (wr == 0) PG8_BAR;
    PG8_BAR;
    if constexpr (Epi::AFTER_DRAIN) { E.fused(acc, cur, wr, wc, fr, fq, lds, wid, lane); S.done(cur); }
#undef PG8_SA
#undef PG8_SB
#undef PG8_STAGE
#undef PG8_LDA
#undef PG8_LDB
#undef PG8_MMA
#undef PG8_WAIT_V
#undef PG8_WAIT_L
#undef PG8_BAR
#undef PG8_SCHED
}
}

using pg8::Unit;
struct EpiBf16 {
    static constexpr bool PERM = false, AFTER_DRAIN = false;
    bf16_t* O; int ldc; int pad;
    __device__ __forceinline__ void operator()(const f32x4 (&acc)[2][2][4][2], const Unit& u, int wr, int wc, int fr, int fq) const {
        const int row0 = u.pm * 256 + wr * 64 + fr, col0 = u.pn * 256 + wc * 32 + 4 * fq;
#pragma unroll
        for (int ai = 0; ai < 2; ++ai)
#pragma unroll
            for (int m = 0; m < 4; ++m) { bf16_t* rowp = O + (size_t)(row0 + ai * 128 + m * 16) * ldc + col0;
#pragma unroll
                for (int bj = 0; bj < 2; ++bj)
#pragma unroll
                    for (int n = 0; n < 2; ++n) { const f32x4 v = acc[ai][bj][m][n]; u32x2 o; o.x = pk2(v[0], v[1]); o.y = pk2(v[2], v[3]); *(u32x2*)(rowp + bj * 128 + n * 16) = o; } }
    }
};
struct EpiF32 {
    static constexpr bool PERM = false, AFTER_DRAIN = false;
    float* O; int ldc; int pad;
    __device__ __forceinline__ void operator()(const f32x4 (&acc)[2][2][4][2], const Unit& u, int wr, int wc, int fr, int fq) const {
        const int row0 = u.pm * 256 + wr * 64 + fr, col0 = u.pn * 256 + wc * 32 + 4 * fq;
#pragma unroll
        for (int ai = 0; ai < 2; ++ai)
#pragma unroll
            for (int m = 0; m < 4; ++m) { float* rowp = O + (size_t)(row0 + ai * 128 + m * 16) * ldc + col0;
#pragma unroll
                for (int bj = 0; bj < 2; ++bj)
#pragma unroll
                    for (int n = 0; n < 2; ++n) *(f32x4*)(rowp + bj * 128 + n * 16) = acc[ai][bj][m][n]; }
    }
};
struct EpiScaleBf16 {
    static constexpr bool PERM = false, AFTER_DRAIN = false;
    bf16_t* O; const float* scale; int ldc; int pad;
    __device__ __forceinline__ void operator()(const f32x4 (&acc)[2][2][4][2], const Unit& u, int wr, int wc, int fr, int fq) const {
        const int row0 = u.pm * 256 + wr * 64 + fr, col0 = u.pn * 256 + wc * 32 + 4 * fq;
        f32x4 sv[2][2];
#pragma unroll
        for (int bj = 0; bj < 2; ++bj)
#pragma unroll
            for (int n = 0; n < 2; ++n) sv[bj][n] = *(const f32x4*)(scale + col0 + bj * 128 + n * 16);
#pragma unroll
        for (int ai = 0; ai < 2; ++ai)
#pragma unroll
            for (int m = 0; m < 4; ++m) { bf16_t* rowp = O + (size_t)(row0 + ai * 128 + m * 16) * ldc + col0;
#pragma unroll
                for (int bj = 0; bj < 2; ++bj)
#pragma unroll
                    for (int n = 0; n < 2; ++n) { const f32x4 v = acc[ai][bj][m][n] * sv[bj][n]; u32x2 o; o.x = pk2(v[0], v[1]); o.y = pk2(v[2], v[3]); *(u32x2*)(rowp + bj * 128 + n * 16) = o; } }
    }
};
struct EpiResid {
    static constexpr bool PERM = false, AFTER_DRAIN = false;
    const float* Xin; float* Xout; const float* gate;
    __device__ __forceinline__ void operator()(const f32x4 (&acc)[2][2][4][2], const Unit& u, int wr, int wc, int fr, int fq) const {
        const int row0 = u.pm * 256 + wr * 64 + fr, col0 = u.pn * 256 + wc * 32 + 4 * fq, b = (u.pm * 256) / SEQ;
        f32x4 gv[2][2];
#pragma unroll
        for (int bj = 0; bj < 2; ++bj)
#pragma unroll
            for (int n = 0; n < 2; ++n) gv[bj][n] = *(const f32x4*)(gate + (size_t)b * 6144 + col0 + bj * 128 + n * 16);
#pragma unroll
        for (int ai = 0; ai < 2; ++ai)
#pragma unroll
            for (int m = 0; m < 4; ++m) { const size_t ro = (size_t)(row0 + ai * 128 + m * 16) * D + col0;
#pragma unroll
                for (int bj = 0; bj < 2; ++bj)
#pragma unroll
                    for (int n = 0; n < 2; ++n) { const f32x4 xi = *(const f32x4*)(Xin + ro + bj * 128 + n * 16); *(f32x4*)(Xout + ro + bj * 128 + n * 16) = xi + gv[bj][n] * acc[ai][bj][m][n]; } }
    }
};
struct EpiConvIn {
    static constexpr bool PERM = false, AFTER_DRAIN = false;
    bf16_t* Bg; bf16_t* Vv;
    __device__ __forceinline__ void operator()(const f32x4 (&acc)[2][2][4][2], const Unit& u, int wr, int wc, int fr, int fq) const {
        const int row0 = u.pm * 256 + wr * 64 + fr, colt = u.pn * 256;
        if (colt < 1024) {
            const int col0 = colt + wc * 32 + 4 * fq;
#pragma unroll
            for (int ai = 0; ai < 2; ++ai)
#pragma unroll
                for (int m = 0; m < 4; ++m) { bf16_t* rowp = Bg + (size_t)(row0 + ai * 128 + m * 16) * D + col0;
#pragma unroll
                    for (int bj = 0; bj < 2; ++bj)
#pragma unroll
                        for (int n = 0; n < 2; ++n) { const f32x4 v = acc[ai][bj][m][n]; u32x2 o; o.x = pk2(v[0], v[1]); o.y = pk2(v[2], v[3]); *(u32x2*)(rowp + bj * 128 + n * 16) = o; } }
        } else {
            const int g0 = (colt - 1024) / 32 + wc;
#pragma unroll
            for (int ai = 0; ai < 2; ++ai)
#pragma unroll
                for (int m = 0; m < 4; ++m) { bf16_t* rowp = Vv + (size_t)(row0 + ai * 128 + m * 16) * D + 4 * fq;
#pragma unroll
                    for (int bj = 0; bj < 2; ++bj) { const f32x4 v = acc[ai][bj][m][0] * acc[ai][bj][m][1]; u32x2 o; o.x = pk2(v[0], v[1]); o.y = pk2(v[2], v[3]);
                        *(u32x2*)(rowp + (g0 + 4 * bj) * 16) = o; } }
        }
    }
};

constexpr size_t al256(size_t x) { return (x + 255) & ~(size_t)255; }
constexpr size_t WS_CTL  = 0;
constexpr size_t WS_U16  = al256(WS_CTL + CTL_BYTES);
constexpr size_t WS_V16  = WS_U16 + (size_t)2 * NE * D;
constexpr size_t WS_USC  = WS_V16 + (size_t)2 * NE * D;
constexpr size_t WS_VSC  = WS_USC + (size_t)2 * NE * 4;
constexpr size_t WS_WCI  = WS_VSC + (size_t)2 * NE * 4;
constexpr size_t WS_WCO  = WS_WCI + (size_t)3072 * D * 2;
constexpr size_t WS_WPI  = WS_WCO + (size_t)D * D * 2;
constexpr size_t WS_WPG  = WS_WPI + (size_t)D * D * 2;
constexpr size_t WS_WPO  = WS_WPG + (size_t)4 * 256 * 256 * 2;
constexpr size_t WS_WQ   = WS_WPO + (size_t)D * D * 2;
constexpr size_t WS_KBD  = WS_WQ + (size_t)2 * 2048 * D * 2;
constexpr size_t WS_MOD  = WS_KBD + (size_t)2 * 2 * 128 * 128 * 2;
constexpr size_t WS_HH   = al256(WS_MOD + (size_t)2 * 8 * 6144 * 4);
constexpr size_t WS_BG   = WS_HH + (size_t)T * D * 2;
constexpr size_t WS_VV   = WS_BG + (size_t)T * D * 2;
constexpr size_t WS_AA   = WS_VV + (size_t)T * D * 2;
constexpr size_t WS_XA   = WS_AA + (size_t)T * D * 2;
constexpr size_t WS_H2   = WS_XA + (size_t)T * D * 4;
constexpr size_t WS_QQ   = WS_H2 + (size_t)T * D * 2;
constexpr size_t WS_IDX  = WS_QQ + (size_t)T * 2048 * 2;
constexpr size_t WS_GATE = WS_IDX + (size_t)T * NSEL * 4;
constexpr size_t WS_END  = WS_GATE + (size_t)T * NSEL * 4;

struct Params { const float* in[19]; float* out; unsigned char* ws; };

template <int MODE>
__device__ __forceinline__ void transpose_tile(const float* __restrict__ W, bf16_t* __restrict__ Wt, int K, int N, int tn, int tk, float* tile  ) {
    const int tid = otid(), n0 = tn * 64, k0 = tk * 64, tx = tid & 63, ty = tid >> 6;
#pragma unroll
    for (int i = 0; i < 8; ++i) tile[(ty + 8 * i) * 65 + tx] = W[(size_t)(k0 + ty + 8 * i) * N + n0 + tx];
    __syncthreads();
#pragma unroll
    for (int i = 0; i < 8; ++i) {
        int n = n0 + ty + 8 * i, p = n;
        if (MODE == 1 && n >= 1024) { const int j = (n - 1024) & 1023, isu = (n >= 2048); p = 1024 + (j >> 4) * 32 + isu * 16 + (j & 15); }
        Wt[(size_t)p * K + k0 + tx] = (bf16_t)f2bf(tile[tx * 65 + ty + 8 * i]);
    }
    __syncthreads();
}
__device__ __forceinline__ void cvt_rows_fp8(const float* __restrict__ src, unsigned char* __restrict__ dst, float* __restrict__ isc, int R0, int lane) {
    float4 v[2][4];
#pragma unroll
    for (int q = 0; q < 2; ++q)
#pragma unroll
        for (int i = 0; i < 4; ++i) v[q][i] = ((const float4*)(src + (size_t)(R0 + q) * D + lane * 16))[i];
#pragma unroll
    for (int q = 0; q < 2; ++q) {
        float m = 0.f;
#pragma unroll
        for (int i = 0; i < 4; ++i) m = fmaxf(m, fmaxf(fmaxf(fabsf(v[q][i].x), fabsf(v[q][i].y)), fmaxf(fabsf(v[q][i].z), fabsf(v[q][i].w))));
#pragma unroll
        for (int o = 32; o > 0; o >>= 1) m = fmaxf(m, shx(m, o, lane));
        const float ratio = m > 1e-30f ? 224.0f / m : 1.0f;
        const float sc = __builtin_bit_cast(float, __builtin_bit_cast(unsigned, ratio) & 0x7f800000u);
        int w[4];
#pragma unroll
        for (int i = 0; i < 4; ++i) { int t = 0; t = __builtin_amdgcn_cvt_pk_fp8_f32(v[q][i].x * sc, v[q][i].y * sc, t, false); t = __builtin_amdgcn_cvt_pk_fp8_f32(v[q][i].z * sc, v[q][i].w * sc, t, true); w[i] = t; }
        const int R = R0 + q, l = R >> 14, e = R & (NE - 1), sl = lane >> 3;
        *(int4*)(dst + (((size_t)(l * 8 + sl) * NE + e) << 7) + (lane & 7) * 16) = make_int4(w[0], w[1], w[2], w[3]);
        if (lane == 0) isc[R] = 1.0f / sc;
    }
}
__device__ __forceinline__ void k12_item(const float* __restrict__ k1, const float* __restrict__ k2, bf16_t* __restrict__ K12, int item) {
    const int tid = otid(), l = item >> 1, half = item & 1;
    const float* src = (half ? k2 : k1) + (size_t)l * 16384;
#pragma unroll
    for (int i = 0; i < 8; ++i) { const int e4 = i * NT + tid; const float4 v = ((const float4*)src)[e4]; u32x2 o; o.x = pk2(v.x, v.y); o.y = pk2(v.z, v.w); ((u32x2*)(K12 + (size_t)item * 16384))[e4] = o; }
}
__device__ __forceinline__ void mod_item(const float* __restrict__ cact, const float* __restrict__ w_mod, const float* __restrict__ b_mod, float* __restrict__ mod, int item, float* red  ) {
    const int tid = otid(), l = item / 96, n0 = (item % 96) * 64, col = tid & 63, kg = tid >> 6;
    float acc[8] = {0, 0, 0, 0, 0, 0, 0, 0};
    const float* w = w_mod + (size_t)l * D * 6144 + (size_t)(kg * 128) * 6144 + n0 + col;
#pragma unroll 8
    for (int k = 0; k < 128; ++k) { const float wv = w[(size_t)k * 6144];
#pragma unroll
        for (int b = 0; b < 8; ++b) acc[b] += cact[b * D + kg * 128 + k] * wv; }
#pragma unroll
    for (int b = 0; b < 8; ++b) red[(kg * 8 + b) * 64 + col] = acc[b];
    __syncthreads();
    { const int b = tid >> 6, cc = tid & 63; float s = b_mod[l * 6144 + n0 + cc];
#pragma unroll
      for (int q = 0; q < 8; ++q) s += red[(q * 8 + b) * 64 + cc];
      mod[((size_t)l * 8 + b) * 6144 + n0 + cc] = s; }
    __syncthreads();
}

template <int MODE>
__device__ __forceinline__ void rmsnorm_row(const float* x, const float* __restrict__ g, const float* __restrict__ sh, const float* __restrict__ sc, bf16_t* ob, float* of, int row, int lane) {
    const int b = row / SEQ;
    const float4* xr = (const float4*)(x + (size_t)row * D);
    float4 v[4]; float ss = 0.f;
#pragma unroll
    for (int i = 0; i < 4; ++i) { v[i] = xr[lane + 64 * i]; ss += v[i].x * v[i].x + v[i].y * v[i].y + v[i].z * v[i].z + v[i].w * v[i].w; }
    ss = wave_sum(ss, lane);
    const float r = rsqrtf(ss * (1.0f / D) + EPS);
#pragma unroll
    for (int i = 0; i < 4; ++i) {
        const int c4 = lane + 64 * i; const float4 gg = ((const float4*)g)[c4];
        float4 y; y.x = v[i].x * r * gg.x; y.y = v[i].y * r * gg.y; y.z = v[i].z * r * gg.z; y.w = v[i].w * r * gg.w;
        if (MODE == 0) {
            const float4 s1 = ((const float4*)(sc + (size_t)b * 6144))[c4], s0 = ((const float4*)(sh + (size_t)b * 6144))[c4];
            y.x = y.x * (1.f + s1.x) + s0.x; y.y = y.y * (1.f + s1.y) + s0.y; y.z = y.z * (1.f + s1.z) + s0.z; y.w = y.w * (1.f + s1.w) + s0.w;
            uint2 o; o.x = pk2(y.x, y.y); o.y = pk2(y.z, y.w);
            ((uint2*)(ob + (size_t)row * D))[c4] = o;
        } else ((float4*)(of + (size_t)row * D))[c4] = y;
    }
}
__device__ __forceinline__ int ord_key(float f) { const int b = __builtin_bit_cast(int, f); return b >= 0 ? b : (b ^ 0x7fffffff); }
__device__ __forceinline__ float key_val(int k) { const int b = k >= 0 ? k : (k ^ 0x7fffffff); return __builtin_bit_cast(float, b); }
__device__ __forceinline__ void ce(int& hi, int& lo) { const int a = hi, b = lo; hi = a > b ? a : b; lo = a > b ? b : a; }
__device__ __forceinline__ void sort16_desc(int (&v)[16]) {
#pragma unroll
    for (int ks = 1; ks <= 4; ++ks)
#pragma unroll
        for (int js = ks - 1; js >= 0; --js)
#pragma unroll
            for (int i = 0; i < 16; ++i) { const int k = 1 << ks, j = 1 << js, l = i ^ j; if (l > i) { if ((i & k) == 0) ce(v[i], v[l]); else ce(v[l], v[i]); } }
}
__device__ __forceinline__ void merge16_desc(int (&a)[16], const int (&b)[16]) {
#pragma unroll
    for (int i = 0; i < 16; ++i) a[i] = a[i] > b[15 - i] ? a[i] : b[15 - i];
#pragma unroll
    for (int js = 3; js >= 0; --js)
#pragma unroll
        for (int i = 0; i < 16; ++i) { const int j = 1 << js, l = i ^ j; if (l > i) ce(a[i], a[l]); }
}
__host__ __device__ constexpr int cand_ij(int c) { int n = 0; for (int i = 0; i < 16; ++i) for (int j = 0; j < 16; ++j) if ((i + 1) * (j + 1) <= 16) { if (n == c) return i * 16 + j; ++n; } return -1; }
constexpr int NCAND = 50;
static_assert(cand_ij(NCAND - 1) >= 0 && cand_ij(NCAND) < 0, "candidate count");
template <int C> __device__ __forceinline__ void cand_step(const float (&v1)[16], const float (&v2)[16], int (&cur)[16], int (&run)[16]) {
    constexpr int ij = cand_ij(C), i = ij >> 4, j = ij & 15;
    cur[C & 15] = (ord_key(v1[i] + v2[j]) & ~255) | ij;
    if constexpr ((C & 15) == 15 || C == NCAND - 1) {
        if constexpr (C == NCAND - 1) {
#pragma unroll
            for (int q = (C & 15) + 1; q < 16; ++q) cur[q] = (int)0x80000000;
        }
        sort16_desc(cur);
        if constexpr (C == 15) {
#pragma unroll
            for (int q = 0; q < 16; ++q) run[q] = cur[q];
        } else merge16_desc(run, cur);
    }
}
template <int... C> __device__ __forceinline__ void cand_all(std::integer_sequence<int, C...>, const float (&v1)[16], const float (&v2)[16], int (&cur)[16], int (&run)[16]) { (cand_step<C>(v1, v2, cur, run), ...); }
__device__ __forceinline__ void top16_of_128(const float* __restrict__ s, int (&run)[16]) {
#pragma unroll 1
    for (int g = 0; g < 8; ++g) {
        int cur[16];
#pragma unroll
        for (int q = 0; q < 4; ++q) { const float4 v = ((const float4*)s)[g * 4 + q];
            cur[4 * q + 0] = (ord_key(v.x) & ~127) | (g * 16 + 4 * q + 0); cur[4 * q + 1] = (ord_key(v.y) & ~127) | (g * 16 + 4 * q + 1);
            cur[4 * q + 2] = (ord_key(v.z) & ~127) | (g * 16 + 4 * q + 2); cur[4 * q + 3] = (ord_key(v.w) & ~127) | (g * 16 + 4 * q + 3); }
        sort16_desc(cur);
        if (g == 0) {
#pragma unroll
            for (int i = 0; i < 16; ++i) run[i] = cur[i];
        } else merge16_desc(run, cur);
    }
}
__device__ __forceinline__ int lut16(const int (&p)[4], int i) {
    const int r = i >> 2; const int w = r == 0 ? p[0] : (r == 1 ? p[1] : (r == 2 ? p[2] : p[3]));
    return (w >> ((i & 3) * 8)) & 127;
}
typedef float f32x16 __attribute__((ext_vector_type(16)));
__device__ __forceinline__ int shxi(int v, int m, int lane) { return __builtin_amdgcn_ds_bpermute((lane ^ m) << 2, v); }
__device__ __forceinline__ void st_half32(const bf16_t* __restrict__ qrow  , const unsigned char* kl  , int (&top)[16], int lane) {
    const int r = lane & 31, h = lane >> 5;
    bf16x8 bq[8];
#pragma unroll
    for (int ks = 0; ks < 8; ++ks) bq[ks] = *(const bf16x8*)(qrow + ks * 16);
    int run[16];
#pragma unroll
    for (int i = 0; i < 16; ++i) run[i] = (int)0x80000000;
#pragma unroll 1
    for (int tl = 0; tl < 4; ++tl) {
        f32x16 acc;
#pragma unroll
        for (int i = 0; i < 16; ++i) acc[i] = 0.f;
        const int row = tl * 32 + r;
#pragma unroll
        for (int ks = 0; ks < 8; ++ks) { const bf16x8 ak = *(const bf16x8*)(kl + row * 256 + ((((ks * 2 + h) ^ row) & 15) << 4));
            acc = __builtin_amdgcn_mfma_f32_32x32x16_bf16(ak, bq[ks], acc, 0, 0, 0); }
        int g[16];
#pragma unroll
        for (int i = 0; i < 16; ++i) g[i] = (ord_key(acc[i]) & ~127) | (tl * 32 + (i & 3) + 8 * (i >> 2) + 4 * h);
        sort16_desc(g); merge16_desc(run, g);
    }
    { int b[16];
#pragma unroll
      for (int i = 0; i < 16; ++i) b[i] = shxi(run[i], 32, lane);
      merge16_desc(run, b); }
#pragma unroll
    for (int i = 0; i < 16; ++i) top[i] = run[i];
}
__device__ __forceinline__ void st_tokens64(const bf16_t* __restrict__ Qq, const unsigned char* klds  , int* __restrict__ IDX, float* __restrict__ GATE, int t0, int head, int lane) {
    const int c = lane & 31, h = lane >> 5;
    int k1[16], k2[16];
#pragma unroll 1
    for (int sub = 0; sub < 2; ++sub) {
        const bf16_t* qrow = Qq + (size_t)(t0 + sub * 32 + c) * 2048 + head * 256 + h * 8;
        int a1[16], a2[16];
        st_half32(qrow, klds, a1, lane);
        st_half32(qrow + 128, klds + 32768, a2, lane);
        if (sub == 0) {
#pragma unroll
            for (int i = 0; i < 16; ++i) { k1[i] = a1[i]; k2[i] = a2[i]; }
        } else {
#pragma unroll
            for (int i = 0; i < 16; ++i) { k1[i] = h ? a1[i] : k1[i]; k2[i] = h ? a2[i] : k2[i]; }
        }
    }
    const int t = t0 + lane;
    float v1[16], v2[16]; int id1[4] = {0, 0, 0, 0}, id2[4] = {0, 0, 0, 0};
#pragma unroll
    for (int i = 0; i < 16; ++i) { v1[i] = key_val(k1[i] & ~127); v2[i] = key_val(k2[i] & ~127); id1[i >> 2] |= (k1[i] & 127) << ((i & 3) * 8); id2[i >> 2] |= (k2[i] & 127) << ((i & 3) * 8); }
    int run[16];
    { int cur[16]; cand_all(std::make_integer_sequence<int, NCAND>{}, v1, v2, cur, run); }
    float e[16], sum = 0.f; const float s0 = key_val(run[0] & ~255);
#pragma unroll
    for (int i = 0; i < 16; ++i) { e[i] = __expf(key_val(run[i] & ~255) - s0); sum += e[i]; }
    const float inv = 1.0f / sum;
    int* io = IDX + (size_t)t * NSEL + head * 16; float* go = GATE + (size_t)t * NSEL + head * 16;
#pragma unroll
    for (int q = 0; q < 4; ++q) {
        int4 iv; float4 gv;
        { const int f = run[4 * q + 0] & 255; iv.x = lut16(id1, f >> 4) * 128 + lut16(id2, f & 15); gv.x = e[4 * q + 0] * inv; }
        { const int f = run[4 * q + 1] & 255; iv.y = lut16(id1, f >> 4) * 128 + lut16(id2, f & 15); gv.y = e[4 * q + 1] * inv; }
        { const int f = run[4 * q + 2] & 255; iv.z = lut16(id1, f >> 4) * 128 + lut16(id2, f & 15); gv.z = e[4 * q + 2] * inv; }
        { const int f = run[4 * q + 3] & 255; iv.w = lut16(id1, f >> 4) * 128 + lut16(id2, f & 15); gv.w = e[4 * q + 3] * inv; }
        ((int4*)io)[q] = iv; ((float4*)go)[q] = gv;
    }
}

__device__ __forceinline__ void conv_elem8(const bf16_t* __restrict__ Bg, const bf16_t* __restrict__ Vv, const float* __restrict__ cw, bf16_t* __restrict__ Aa, size_t i) {
    const int t = (int)(i >> 7), c8 = (int)(i & 127), s = t & (SEQ - 1);
    const uint4 b = ((const uint4*)Bg)[i], v2 = ((const uint4*)Vv)[i];
    const uint4 v1 = ((const uint4*)Vv)[s >= 1 ? i - 128 : i], v0 = ((const uint4*)Vv)[s >= 2 ? i - 256 : i];
    const float m1 = s >= 1 ? 1.f : 0.f, m0 = s >= 2 ? 1.f : 0.f;
    const float4 w0a = ((const float4*)cw)[2 * c8], w0b = ((const float4*)cw)[2 * c8 + 1], w1a = ((const float4*)(cw + D))[2 * c8], w1b = ((const float4*)(cw + D))[2 * c8 + 1],
                 w2a = ((const float4*)(cw + 2 * D))[2 * c8], w2b = ((const float4*)(cw + 2 * D))[2 * c8 + 1];
    uint4 o;
    o.x = pk2(bf_lo(b.x) * (m0 * w0a.x * bf_lo(v0.x) + m1 * w1a.x * bf_lo(v1.x) + w2a.x * bf_lo(v2.x)), bf_hi(b.x) * (m0 * w0a.y * bf_hi(v0.x) + m1 * w1a.y * bf_hi(v1.x) + w2a.y * bf_hi(v2.x)));
    o.y = pk2(bf_lo(b.y) * (m0 * w0a.z * bf_lo(v0.y) + m1 * w1a.z * bf_lo(v1.y) + w2a.z * bf_lo(v2.y)), bf_hi(b.y) * (m0 * w0a.w * bf_hi(v0.y) + m1 * w1a.w * bf_hi(v1.y) + w2a.w * bf_hi(v2.y)));
    o.z = pk2(bf_lo(b.z) * (m0 * w0b.x * bf_lo(v0.z) + m1 * w1b.x * bf_lo(v1.z) + w2b.x * bf_lo(v2.z)), bf_hi(b.z) * (m0 * w0b.y * bf_hi(v0.z) + m1 * w1b.y * bf_hi(v1.z) + w2b.y * bf_hi(v2.z)));
    o.w = pk2(bf_lo(b.w) * (m0 * w0b.z * bf_lo(v0.w) + m1 * w1b.z * bf_lo(v1.w) + w2b.z * bf_lo(v2.w)), bf_hi(b.w) * (m0 * w0b.w * bf_hi(v0.w) + m1 * w1b.w * bf_hi(v1.w) + w2b.w * bf_hi(v2.w)));
    ((uint4*)Aa)[i] = o;
}
template <int W>
__device__ __forceinline__ void pool_elem8(const bf16_t* __restrict__ Uu, bf16_t* __restrict__ Pp, int t, int c8  ) {
    const int s = t & (SEQ - 1);
    const size_t i = (size_t)t * 128 + c8;
    uint4 r[W];
#pragma unroll
    for (int k = 0; k < W; ++k) r[k] = ((const uint4*)Uu)[k <= s ? i - (size_t)k * 128 : i];
    float a[8] = {0, 0, 0, 0, 0, 0, 0, 0};
#pragma unroll
    for (int k = 0; k < W; ++k) { const float m = k <= s ? 1.f : 0.f;
        a[0] += m * bf_lo(r[k].x); a[1] += m * bf_hi(r[k].x); a[2] += m * bf_lo(r[k].y); a[3] += m * bf_hi(r[k].y); a[4] += m * bf_lo(r[k].z); a[5] += m * bf_hi(r[k].z); a[6] += m * bf_lo(r[k].w); a[7] += m * bf_hi(r[k].w); }
    const float inv = 1.0f / (float)(s + 1 < W ? s + 1 : W);
    uint4 o;
    o.x = pk2(a[0] * inv - bf_lo(r[0].x), a[1] * inv - bf_hi(r[0].x)); o.y = pk2(a[2] * inv - bf_lo(r[0].y), a[3] * inv - bf_hi(r[0].y));
    o.z = pk2(a[4] * inv - bf_lo(r[0].z), a[5] * inv - bf_hi(r[0].z)); o.w = pk2(a[6] * inv - bf_lo(r[0].w), a[7] * inv - bf_hi(r[0].w));
    ((uint4*)Pp)[i] = o;
}

__device__ __forceinline__ void topk_pair(const float* __restrict__ S, int* __restrict__ IDX, float* __restrict__ GATE, size_t p) {
    int k1[16], k2[16];
    top16_of_128(S + p * 256, k1);
    top16_of_128(S + p * 256 + 128, k2);
    float v1[16], v2[16]; int id1[4] = {0, 0, 0, 0}, id2[4] = {0, 0, 0, 0};
#pragma unroll
    for (int i = 0; i < 16; ++i) { v1[i] = key_val(k1[i] & ~127); v2[i] = key_val(k2[i] & ~127); id1[i >> 2] |= (k1[i] & 127) << ((i & 3) * 8); id2[i >> 2] |= (k2[i] & 127) << ((i & 3) * 8); }
    int run[16];
    { int cur[16]; cand_all(std::make_integer_sequence<int, NCAND>{}, v1, v2, cur, run); }
    float sc[16], e[16], sum = 0.f;
#pragma unroll
    for (int i = 0; i < 16; ++i) sc[i] = key_val(run[i] & ~255);
#pragma unroll
    for (int i = 0; i < 16; ++i) { e[i] = __expf(sc[i] - sc[0]); sum += e[i]; }
    const float inv = 1.0f / sum;
    int* io = IDX + p * 16; float* go = GATE + p * 16;
#pragma unroll
    for (int q = 0; q < 4; ++q) {
        int4 iv; float4 gv;
        { const int f = run[4 * q + 0] & 255; iv.x = lut16(id1, f >> 4) * 128 + lut16(id2, f & 15); gv.x = e[4 * q + 0] * inv; }
        { const int f = run[4 * q + 1] & 255; iv.y = lut16(id1, f >> 4) * 128 + lut16(id2, f & 15); gv.y = e[4 * q + 1] * inv; }
        { const int f = run[4 * q + 2] & 255; iv.z = lut16(id1, f >> 4) * 128 + lut16(id2, f & 15); gv.z = e[4 * q + 2] * inv; }
        { const int f = run[4 * q + 3] & 255; iv.w = lut16(id1, f >> 4) * 128 + lut16(id2, f & 15); gv.w = e[4 * q + 3] * inv; }
        ((int4*)io)[q] = iv; ((float4*)go)[q] = gv;
    }
}

#define LOAD_IDS16(id, p) { const int4 _a = (p)[0], _b = (p)[1], _c = (p)[2], _d = (p)[3]; id[0] = _a.x; id[1] = _a.y; id[2] = _a.z; id[3] = _a.w; id[4] = _b.x; id[5] = _b.y; id[6] = _b.z; id[7] = _b.w; \
    id[8] = _c.x; id[9] = _c.y; id[10] = _c.z; id[11] = _c.w; id[12] = _d.x; id[13] = _d.y; id[14] = _d.z; id[15] = _d.w; }
#define FP8X2(w, hi) __builtin_amdgcn_cvt_pk_f32_fp8((int)(w), hi)
#define PEER_IDS(tt) { const int _tc = (tt) < t1 ? (tt) : t1 - 1; LOAD_IDS16(idn, (const int4*)(IDX + (size_t)_tc * NSEL + g * 16)); __builtin_amdgcn_sched_barrier(0); }
#define PEER_ROWS(R) { _Pragma("unroll") for (int i = 0; i < 16; ++i) R[i] = *(const uint4*)(tb + (unsigned)idn[i] * 128u); __builtin_amdgcn_sched_barrier(0); }
__device__ __forceinline__ void peer_u_comp(const uint4 (&r)[16], const uint4 h0, const uint4 h1, float* __restrict__ PARTs, int t, int t1, int lane, bool b4, bool b2, bool b1) {
    const f32x2 hp[8] = {{bf_lo(h0.x), bf_hi(h0.x)}, {bf_lo(h0.y), bf_hi(h0.y)}, {bf_lo(h0.z), bf_hi(h0.z)}, {bf_lo(h0.w), bf_hi(h0.w)},
                         {bf_lo(h1.x), bf_hi(h1.x)}, {bf_lo(h1.y), bf_hi(h1.y)}, {bf_lo(h1.z), bf_hi(h1.z)}, {bf_lo(h1.w), bf_hi(h1.w)}};
    float a[16];
#pragma unroll
    for (int i = 0; i < 16; ++i) {
        f32x2 sacc = hp[0] * FP8X2(r[i].x, false);
        sacc += hp[1] * FP8X2(r[i].x, true); sacc += hp[2] * FP8X2(r[i].y, false); sacc += hp[3] * FP8X2(r[i].y, true);
        sacc += hp[4] * FP8X2(r[i].z, false); sacc += hp[5] * FP8X2(r[i].z, true); sacc += hp[6] * FP8X2(r[i].w, false); sacc += hp[7] * FP8X2(r[i].w, true);
        a[i] = sacc.x + sacc.y; }
    float b8[8], c4[4], d2[2];
#pragma unroll
    for (int i = 0; i < 8; ++i) { const float keep = b4 ? a[i + 8] : a[i], send = b4 ? a[i] : a[i + 8]; b8[i] = keep + shx(send, 4, lane); }
#pragma unroll
    for (int i = 0; i < 4; ++i) { const float keep = b2 ? b8[i + 4] : b8[i], send = b2 ? b8[i] : b8[i + 4]; c4[i] = keep + shx(send, 2, lane); }
#pragma unroll
    for (int i = 0; i < 2; ++i) { const float keep = b1 ? c4[i + 2] : c4[i], send = b1 ? c4[i] : c4[i + 2]; d2[i] = keep + shx(send, 1, lane); }
    if (t < t1) *(float2*)(PARTs + (size_t)t * NSEL + lane * 2) = make_float2(d2[0], d2[1]);
}
__device__ __forceinline__ void peer_u_tokens(const bf16_t* __restrict__ H2, const int* __restrict__ IDX, const unsigned char* __restrict__ tab, float* __restrict__ PARTs, int s, int t0, int t1, int lane) {
    if (t0 >= t1) return;
    const int g = lane >> 3, j = lane & 7;
    const unsigned char* tb = tab + j * 16;
    const bool b4 = (j & 4) != 0, b2 = (j & 2) != 0, b1 = (j & 1) != 0;
    const bf16_t* hb = H2 + s * 128 + j * 16;
#define PEER_H(h0, h1, tt) { const int _tc = (tt) < t1 ? (tt) : t1 - 1; h0 = *(const uint4*)(hb + (size_t)_tc * D); h1 = *(const uint4*)(hb + (size_t)_tc * D + 8); }
    int idn[16]; uint4 rA[16], rB[16], hA0, hA1, hB0, hB1;
    PEER_IDS(t0); PEER_ROWS(rA); PEER_H(hA0, hA1, t0); PEER_IDS(t0 + 1);
    for (int t = t0; t < t1; t += 2) {
        PEER_ROWS(rB); PEER_H(hB0, hB1, t + 1); PEER_IDS(t + 2);
        peer_u_comp(rA, hA0, hA1, PARTs, t, t1, lane, b4, b2, b1);
        PEER_ROWS(rA); PEER_H(hA0, hA1, t + 2); PEER_IDS(t + 3);
        peer_u_comp(rB, hB0, hB1, PARTs, t + 1, t1, lane, b4, b2, b1);
    }
#undef PEER_H
}
__device__ __forceinline__ void peer_v_comp(const uint4 (&r)[16], const float4 wa, const float4 wb, const float4 wc, const float4 wd, const float* __restrict__ Xin, const float* __restrict__ g2,
                                            float* __restrict__ Xout, int col, int t, int t1, int lane, bool g4, bool g2b, bool g1) {
    const float w[16] = {wa.x, wa.y, wa.z, wa.w, wb.x, wb.y, wb.z, wb.w, wc.x, wc.y, wc.z, wc.w, wd.x, wd.y, wd.z, wd.w};
    f32x2 acc[8];
#pragma unroll
    for (int k = 0; k < 8; ++k) acc[k] = (f32x2){0.f, 0.f};
#pragma unroll
    for (int i = 0; i < 16; ++i) { const f32x2 ww = {w[i], w[i]};
        acc[0] += ww * FP8X2(r[i].x, false); acc[1] += ww * FP8X2(r[i].x, true); acc[2] += ww * FP8X2(r[i].y, false); acc[3] += ww * FP8X2(r[i].y, true);
        acc[4] += ww * FP8X2(r[i].z, false); acc[5] += ww * FP8X2(r[i].z, true); acc[6] += ww * FP8X2(r[i].w, false); acc[7] += ww * FP8X2(r[i].w, true); }
    f32x2 b4[4], c2[2];
#pragma unroll
    for (int i = 0; i < 4; ++i) { const f32x2 keep = g4 ? acc[i + 4] : acc[i], send = g4 ? acc[i] : acc[i + 4]; b4[i] = (f32x2){keep.x + shx(send.x, 32, lane), keep.y + shx(send.y, 32, lane)}; }
#pragma unroll
    for (int i = 0; i < 2; ++i) { const f32x2 keep = g2b ? b4[i + 2] : b4[i], send = g2b ? b4[i] : b4[i + 2]; c2[i] = (f32x2){keep.x + shx(send.x, 16, lane), keep.y + shx(send.y, 16, lane)}; }
    const f32x2 keep = g1 ? c2[1] : c2[0], send = g1 ? c2[0] : c2[1];
    const f32x2 o = {keep.x + shx(send.x, 8, lane), keep.y + shx(send.y, 8, lane)};
    if (t < t1) { const int b = t / SEQ;
        const float2 xi = *(const float2*)(Xin + (size_t)t * D + col), gg = *(const float2*)(g2 + (size_t)b * 6144 + col);
        *(float2*)(Xout + (size_t)t * D + col) = make_float2(xi.x + gg.x * o.x, xi.y + gg.y * o.y); }
}
__device__ __forceinline__ void peer_v_tokens(const float* __restrict__ W, const int* __restrict__ IDX, const unsigned char* __restrict__ tab, const float* __restrict__ Xin, const float* __restrict__ g2,
                                              float* __restrict__ Xout, int s, int t0, int t1, int lane) {
    if (t0 >= t1) return;
    const int g = lane >> 3, j = lane & 7;
    const unsigned char* tb = tab + j * 16;
    const bool g4 = (g & 4) != 0, g2b = (g & 2) != 0, g1 = (g & 1) != 0;
    const int col = s * 128 + j * 16 + 2 * g;
#define PEER_W(w, tt) { const int _tc = (tt) < t1 ? (tt) : t1 - 1; const float4* _wp = (const float4*)(W + (size_t)_tc * NSEL + g * 16); w##a = _wp[0]; w##b = _wp[1]; w##c = _wp[2]; w##d = _wp[3]; }
    int idn[16]; uint4 rA[16], rB[16]; float4 wAa, wAb, wAc, wAd, wBa, wBb, wBc, wBd;
    PEER_IDS(t0); PEER_ROWS(rA); PEER_W(wA, t0); PEER_IDS(t0 + 1);
    for (int t = t0; t < t1; t += 2) {
        PEER_ROWS(rB); PEER_W(wB, t + 1); PEER_IDS(t + 2);
        peer_v_comp(rA, wAa, wAb, wAc, wAd, Xin, g2, Xout, col, t, t1, lane, g4, g2b, g1);
        PEER_ROWS(rA); PEER_W(wA, t + 2); PEER_IDS(t + 3);
        peer_v_comp(rB, wBa, wBb, wBc, wBd, Xin, g2, Xout, col, t + 1, t1, lane, g4, g2b, g1);
    }
#undef PEER_W
}
struct PeerOwn { int first_slice, slice_step, t0, t1; };
__device__ __forceinline__ PeerOwn peer_own(unsigned* bar, unsigned x, unsigned rank, int wid) {
    unsigned nx = 0, px = 0, nloc = 1;
#pragma unroll
    for (unsigned jx = 0; jx < 16; ++jx) { const unsigned cnt = xb_ld(&bar[XB_XCNT(jx)]); if (jx == x) { px = nx; nloc = cnt ? cnt : 1u; } nx += cnt ? 1u : 0u; }
    if (rank >= nloc) rank = nloc - 1;
    const unsigned nw = nloc * (NT / 64), wr = rank * (NT / 64) + wid;
    PeerOwn o; o.first_slice = (int)px; o.slice_step = (int)(nx ? nx : 1u);
    o.t0 = (int)(((unsigned long long)wr * T) / nw); o.t1 = (int)(((unsigned long long)(wr + 1) * T) / nw);
    return o;
}

constexpr int LDS_MISC = pg8::STAGE_BYTES;
constexpr int LDS_BYTES = pg8::STAGE_BYTES + 256;
extern __shared__ __attribute__((aligned(16))) unsigned char smem[];
#ifndef PROBE_ID
#define PROBE_ID 0
#endif
__global__ void __launch_bounds__(NT, 2) mega_fwd(Params p) {
    unsigned char* lds = smem;
    PG8_LAS unsigned char* ldsl = (PG8_LAS unsigned char*)smem;
    volatile LAS unsigned* bst = (volatile LAS unsigned*)(smem + LDS_MISC);
    unsigned char* ws = p.ws;
    if (threadIdx.x == 0) { bst[0] = 0u; bst[1] = 0u; bst[2] = xb_add((unsigned*)(ws + WS_CTL) + XB_RANK(xb_xcc_id()), 1u); }
    __syncthreads();
    const XcdBarrier bar = xcd_barrier_post((unsigned*)(ws + WS_CTL), bst);
#define GRID_SYNC() xcd_barrier(bar)
#define PH_BEGIN(id) for (int _rep = 0; _rep < ((PROBE_ID) == (id) ? 3 : 1); ++_rep) {
#define PH_END() GRID_SYNC(); }
    if (threadIdx.x < 20) ((const float**)(ws + WS_CTL + PTAB_OFF))[threadIdx.x] = threadIdx.x < 19 ? p.in[threadIdx.x] : (const float*)p.out;
#define INP(i) ld_uniform_ptr(ws + WS_CTL + PTAB_OFF, (i))
    unsigned char* U8 = ws + WS_U16; unsigned char* V8 = ws + WS_V16; float* USC = (float*)(ws + WS_USC); float* VSC = (float*)(ws + WS_VSC);
    bf16_t* Wci = (bf16_t*)(ws + WS_WCI); bf16_t* Wco = (bf16_t*)(ws + WS_WCO); bf16_t* Wpi = (bf16_t*)(ws + WS_WPI); bf16_t* Wpg = (bf16_t*)(ws + WS_WPG); bf16_t* Wpo = (bf16_t*)(ws + WS_WPO);
    bf16_t* Wq = (bf16_t*)(ws + WS_WQ); bf16_t* K12 = (bf16_t*)(ws + WS_KBD);
    float* mod = (float*)(ws + WS_MOD);
    bf16_t* Hh = (bf16_t*)(ws + WS_HH); bf16_t* Bg = (bf16_t*)(ws + WS_BG); bf16_t* Vv = (bf16_t*)(ws + WS_VV); bf16_t* Aa = (bf16_t*)(ws + WS_AA);
    float* XA = (float*)(ws + WS_XA); bf16_t* H2 = (bf16_t*)(ws + WS_H2); bf16_t* Qq = (bf16_t*)(ws + WS_QQ);
    int* IDX = (int*)(ws + WS_IDX); float* GATE = (float*)(ws + WS_GATE);
    float* PART = (float*)(ws + WS_HH);
    float* Wg = (float*)(ws + WS_QQ);
    const int G = gridDim.x;
    pg8::StaticOrder so;

    PH_BEGIN(1)
        constexpr int N_UV = 2 * NE / 16;
        constexpr int I_U = 0, I_V = I_U + N_UV, I_KB = I_V + N_UV, I_CI = I_KB + 4, I_CO = I_CI + 48 * 16, I_PI = I_CO + 256, I_PG = I_PI + 256, I_PO = I_PG + 64,
                      I_WQ = I_PO + 256, I_MOD = I_WQ + 2 * 32 * 16, I_END = I_MOD + 192;
        float* cact = (float*)(lds + 32768);
        if ((int)blockIdx.x + ((I_END - I_MOD + G - 1) / G) * 0 >= 0) { const int tid = otid(); for (int i = tid; i < 8 * D; i += NT) { const float v = p.in[1][i]; cact[i] = v / (1.0f + __expf(-v)); } }
        __syncthreads();
        for (int w0 = blockIdx.x; w0 < I_END; w0 += G) {
            const int w = (w0 < 192) ? (I_MOD + w0) : (w0 - 192);
            if (w < I_V) { const int tid = otid(); cvt_rows_fp8(p.in[16], U8, USC, (w - I_U) * 16 + (tid >> 6) * 2, tid & 63); }
            else if (w < I_KB) { const int tid = otid(); cvt_rows_fp8(p.in[17], V8, VSC, (w - I_V) * 16 + (tid >> 6) * 2, tid & 63); }
            else if (w < I_CI) k12_item(p.in[14], p.in[15], K12, w - I_KB);
            else if (w < I_CO) { const int i = w - I_CI; transpose_tile<1>(p.in[6], Wci, D, 3072, i % 48, i / 48, (float*)lds); }
            else if (w < I_PI) { const int i = w - I_CO; transpose_tile<0>(p.in[8], Wco, D, D, i % 16, i / 16, (float*)lds); }
            else if (w < I_PG) { const int i = w - I_PI; transpose_tile<0>(p.in[9], Wpi, D, D, i % 16, i / 16, (float*)lds); }
            else if (w < I_PO) { const int i = w - I_PG, g = i >> 4, j = i & 15; transpose_tile<0>(p.in[10] + (size_t)g * 65536, Wpg + (size_t)g * 65536, 256, 256, j % 4, j / 4, (float*)lds); }
            else if (w < I_WQ) { const int i = w - I_PO; transpose_tile<0>(p.in[12], Wpo, D, D, i % 16, i / 16, (float*)lds); }
            else if (w < I_MOD) { const int i = w - I_WQ, l = i >> 9, j = i & 511; transpose_tile<0>(p.in[13] + (size_t)l * D * 2048, Wq + (size_t)l * 2048 * D, D, 2048, j % 32, j / 32, (float*)lds); }
            else mod_item(cact, p.in[4], p.in[5], mod, w - I_MOD, (float*)lds);
        }
    PH_END()

    const float* xin = INP(0);
    for (int l = 0; l < 2; ++l) {
        const float* ml = mod + (size_t)l * 8 * 6144;
        float* x1 = XA; float* x2 = (float*)INP(19);
        PH_BEGIN(2) { const int tid = otid(); for (int r = blockIdx.x * 8 + (tid >> 6); r < T; r += G * 8) rmsnorm_row<0>(xin, INP(2) + l * D, ml + 0, ml + 1024, Hh, nullptr, r, tid & 63); } PH_END()
        if (l == 0) {
            PH_BEGIN(3) so.init(T, 3072, G, blockIdx.x); pg8::gemm_phase(ldsl, pg8::Gemm{Hh, Wci, D, D, D, 0}, so, EpiConvIn{Bg, Vv}); PH_END()
            PH_BEGIN(4) { const float* cw = INP(7); const size_t i0 = (size_t)blockIdx.x * NT + otid(), st = (size_t)G * NT;
                for (size_t i = i0; i < (size_t)T * D / 8; i += 2 * st) { conv_elem8(Bg, Vv, cw, Aa, i); if (i + st < (size_t)T * D / 8) conv_elem8(Bg, Vv, cw, Aa, i + st); } } PH_END()
            PH_BEGIN(3) so.init(T, D, G, blockIdx.x); pg8::gemm_phase(ldsl, pg8::Gemm{Aa, Wco, D, D, D, 0}, so, EpiResid{xin, x1, ml + 2048}); PH_END()
        } else {
            PH_BEGIN(3) so.init(T, D, G, blockIdx.x); pg8::gemm_phase(ldsl, pg8::Gemm{Hh, Wpi, D, D, D, 0}, so, EpiBf16{Bg, D, 0}); PH_END()
            PH_BEGIN(4) { const int tid = otid(), wv = tid >> 6, lane = tid & 63;
                for (int it = blockIdx.x * 8 + wv; it < (T / 2) * 4; it += G * 8) { const int grp = it & 3, t = (it >> 2) * 2 + (lane >> 5), c8 = grp * 32 + (lane & 31);
                    if (grp == 0) pool_elem8<2>(Bg, Vv, t, c8); else if (grp == 1) pool_elem8<4>(Bg, Vv, t, c8); else if (grp == 2) pool_elem8<8>(Bg, Vv, t, c8); else pool_elem8<16>(Bg, Vv, t, c8); } } PH_END()
            PH_BEGIN(3) so.init(T, D, G, blockIdx.x); pg8::gemm_phase(ldsl, pg8::Gemm{Vv, Wpg, D, 256, 256, 512}, so, EpiScaleBf16{Aa, INP(11), D, 0}); PH_END()
            PH_BEGIN(3) so.init(T, D, G, blockIdx.x); pg8::gemm_phase(ldsl, pg8::Gemm{Aa, Wpo, D, D, D, 0}, so, EpiResid{xin, x1, ml + 2048}); PH_END()
        }
        PH_BEGIN(2) { const int tid = otid(); for (int r = blockIdx.x * 8 + (tid >> 6); r < T; r += G * 8) rmsnorm_row<0>(x1, INP(3) + l * D, ml + 3072, ml + 4096, H2, nullptr, r, tid & 63); } PH_END()
        PH_BEGIN(3) so.init(T, 2048, G, blockIdx.x); pg8::gemm_phase(ldsl, pg8::Gemm{H2, Wq + (size_t)l * 2048 * D, D, D, D, 0}, so, EpiBf16{Qq, 2048, 0}); PH_END()
        PH_BEGIN(5) {
            const int tid = otid(), lane = tid & 63, wv = tid >> 6;
            __syncthreads();
#pragma unroll
            for (int i = 0; i < 8; ++i) { const int ch = i * NT + tid, half = ch >> 11, n = (ch >> 4) & 127, cc = ch & 15;
                *(uint4*)(lds + half * 32768 + n * 256 + ((cc ^ (n & 15)) << 4)) = ((const uint4*)(K12 + (size_t)l * 32768))[ch]; }
            __syncthreads();
            for (int it = blockIdx.x * 8 + wv; it < (T / 64) * 8; it += G * 8) st_tokens64(Qq, lds, IDX, GATE, (it >> 3) * 64, it & 7, lane);
        } PH_END()
        PH_BEGIN(7) {
            const int tid = otid(), lane = tid & 63;
            const PeerOwn own = peer_own(bar.bar, bar.x, bst[2], tid >> 6);
            for (int sl = own.first_slice; sl < 8; sl += own.slice_step)
                peer_u_tokens(H2, IDX, U8 + ((size_t)l * 8 + sl) * NE * 128, PART + (size_t)sl * T * NSEL, sl, own.t0, own.t1, lane);
        } PH_END()
        PH_BEGIN(8) for (size_t i = (size_t)blockIdx.x * NT + otid(); i < (size_t)T * NSEL / 4; i += (size_t)G * NT) {
            float4 a = ((const float4*)PART)[i];
#pragma unroll
            for (int sl = 1; sl < 8; ++sl) { const float4 q = ((const float4*)(PART + (size_t)sl * T * NSEL))[i]; a.x += q.x; a.y += q.y; a.z += q.z; a.w += q.w; }
            const float4 gt = ((const float4*)GATE)[i]; const int4 id = ((const int4*)IDX)[i];
            const float* us = USC + (size_t)l * NE; const float* vs = VSC + (size_t)l * NE;
            a.x *= us[id.x]; a.y *= us[id.y]; a.z *= us[id.z]; a.w *= us[id.w];
            float4 o;
            o.x = gt.x * vs[id.x] * 0.5f * a.x * (1.0f + erff(a.x * 0.70710678118654752f)); o.y = gt.y * vs[id.y] * 0.5f * a.y * (1.0f + erff(a.y * 0.70710678118654752f));
            o.z = gt.z * vs[id.z] * 0.5f * a.z * (1.0f + erff(a.z * 0.70710678118654752f)); o.w = gt.w * vs[id.w] * 0.5f * a.w * (1.0f + erff(a.w * 0.70710678118654752f));
            ((float4*)Wg)[i] = o;
        } PH_END()
        PH_BEGIN(9) {
            const int tid = otid(), lane = tid & 63;
            const PeerOwn own = peer_own(bar.bar, bar.x, bst[2], tid >> 6);
            for (int sl = own.first_slice; sl < 8; sl += own.slice_step)
                peer_v_tokens(Wg, IDX, V8 + ((size_t)l * 8 + sl) * NE * 128, x1, ml + 5120, x2, sl, own.t0, own.t1, lane);
        } PH_END()
        xin = x2;
    }
    { float* XB = (float*)INP(19); const float* fg = INP(18); const int tid = otid(); for (int r = blockIdx.x * 8 + (tid >> 6); r < T; r += G * 8) rmsnorm_row<1>(XB, fg, nullptr, nullptr, nullptr, XB, r, tid & 63); }
}

extern "C" void kernel_launch(void* const* d_in, const int* in_sizes, int n_in, void* d_out, int out_size, void* d_ws, size_t ws_size, hipStream_t stream) {
    static int grid = 0;
    if (grid == 0) {
        if (n_in != 19 || ws_size < WS_END) { fprintf(stderr, "kernel_launch: expected 19 inputs and >= %zu bytes of workspace (got %d, %zu)\n", (size_t)WS_END, n_in, ws_size); grid = -1; return; }
        int dev = 0, cus = 0, per_cu = 0;
        (void)hipGetDevice(&dev);
        (void)hipDeviceGetAttribute(&cus, hipDeviceAttributeMultiprocessorCount, dev);
        if (hipFuncSetAttribute((const void*)mega_fwd, hipFuncAttributeMaxDynamicSharedMemorySize, LDS_BYTES) != hipSuccess) { fprintf(stderr, "kernel_launch: cannot get %d bytes of dynamic LDS\n", LDS_BYTES); grid = -1; return; }
        (void)hipOccupancyMaxActiveBlocksPerMultiprocessor(&per_cu, (const void*)mega_fwd, NT, LDS_BYTES);
        if (per_cu < 1) { fprintf(stderr, "kernel_launch: occupancy query says %d blocks per CU\n", per_cu); grid = -1; return; }
        grid = cus;
        fprintf(stderr, "kernel_launch: %d CUs, occupancy query %d block(s) per CU, grid %d\n", cus, per_cu, grid);
    }
    if (grid < 0) return;
    (void)hipMemsetAsync((unsigned char*)d_ws + WS_CTL, 0, CTL_BYTES, stream);
    Params p{};
    for (int i = 0; i < 19; ++i) p.in[i] = (const float*)d_in[i];
    p.out = (float*)d_out; p.ws = (unsigned char*)d_ws;
    void* args[] = {&p};
    hipError_t e = hipLaunchCooperativeKernel((const void*)mega_fwd, dim3(grid), dim3(NT), args, LDS_BYTES, stream);
    if (e != hipSuccess) fprintf(stderr, "kernel_launch: cooperative launch failed: %s (grid %d)\n", hipGetErrorString(e), grid);
}
```
